# Optimizing an MI355X kernel written in HIP

```python
import math, functools
import jax, jax.numpy as jnp
from jax import lax
import numpy as np

D_MODEL = 2048
BATCH = 32
SEQ = 256
DEPTH = 4
DEC_BATCH = 2
DEC_SEQ = 2048
PAST_LEN = 256

GRID_W = 64
HEAD_DIM = 64
N_EVEN = (DEPTH + 1) // 2
N_ODD = DEPTH // 2
A_HEADS = D_MODEL // (2 * HEAD_DIM)
A_WIDTH = A_HEADS * HEAD_DIM
A_DECAY_RANK = 64
A_ICL_RANK = 64
A_GATE_RANK = 160
A_COLS = 3 * A_WIDTH + A_GATE_RANK + 2 * A_DECAY_RANK + 2 * A_ICL_RANK
A_SPLITS = (A_WIDTH, 2 * A_WIDTH, 3 * A_WIDTH, 3 * A_WIDTH + A_GATE_RANK, 3 * A_WIDTH + A_GATE_RANK + 2 * A_DECAY_RANK)
RWKV_DECAY_SCALE = 0.6065306597126334
RWKV_GN_EPS = 64e-5
B_HEADS = D_MODEL // (2 * HEAD_DIM)
B_KDIM = 64
B_VDIM = 64
B_FDIM = B_HEADS * B_KDIM
B_WIDTH = B_HEADS * B_VDIM
B_COLS = 3 * B_FDIM + 2 * B_WIDTH
B_SPLITS = (B_FDIM, B_FDIM + B_WIDTH, B_FDIM + 2 * B_WIDTH)
HGRN_CHUNK = 16
EVEN_COLS = A_COLS + B_COLS
C_HEADS = D_MODEL // (2 * HEAD_DIM)
C_WIDTH = C_HEADS * HEAD_DIM
NA_ROWS = 8
NA_COLS = 16
D_HEADS = D_MODEL // (4 * HEAD_DIM)
D_HEAD_DIM = HEAD_DIM
D_V_DIM = 2 * D_HEAD_DIM
D_WIDTH = D_HEADS * 2 * D_HEAD_DIM
D_OUT = D_HEADS * D_V_DIM
ODD_SPLITS = (C_WIDTH, 2 * C_WIDTH, 3 * C_WIDTH, 3 * C_WIDTH + D_WIDTH, 3 * C_WIDTH + 2 * D_WIDTH)
ODD_COLS = 3 * C_WIDTH + 2 * D_WIDTH + D_OUT
Q_BLOCK = 128
ROPE_PAIRS = D_HEAD_DIM // 4
ROPE_BASE = 10000.0
D_FF = 5504
N_MOD = 9
NORM_EPS = 1e-6

kernel_name = 'hybrid_rwkv7_hgrn2_natten_diffattn_dit_step'


def rmsnorm(x, w):
    xf = x.astype(jnp.float32)
    y = xf * lax.rsqrt(jnp.mean(xf * xf, axis=-1, keepdims=True) + NORM_EPS)
    return (y * w.astype(jnp.float32)).astype(x.dtype)


def modulate(h, shift, scale):
    return h * (1 + scale) + shift


def swiglu(h, w1, w2):
    gate, up = jnp.split(jnp.einsum('btd,df->btf', h, w1), 2, axis=-1)
    return jnp.einsum('btf,fd->btd', jax.nn.silu(gate) * up, w2)


def adaln_mod(cond, w, b):
    return jnp.einsum('bd,dm->bm', jax.nn.silu(cond), w) + b


def sandwich_layer(x, mod, norm_w, w1, w2, mixer):
    sh1, sc1, g1, sh2, sc2, g2, sh3, sc3, g3 = jnp.split(mod[:, None, :], N_MOD, axis=-1)
    x = x + 0.5 * g1 * rmsnorm(swiglu(modulate(rmsnorm(x, norm_w[0]), sh1, sc1), w1[0], w2[0]), norm_w[1])
    y, aux = mixer(modulate(rmsnorm(x, norm_w[2]), sh2, sc2))
    x = x + g2 * rmsnorm(y, norm_w[3])
    x = x + 0.5 * g3 * rmsnorm(swiglu(modulate(rmsnorm(x, norm_w[4]), sh3, sc3), w1[1], w2[1]), norm_w[5])
    return x, aux


def centred_shift(u):
    pad = jnp.pad(u, ((0, 0), (1, 1), (0, 0)))
    return 0.5 * (pad[:, :-2] + pad[:, 2:])


def with_dirs(u):
    return jnp.broadcast_to(u[:, :, None], u.shape[:2] + (2,) + u.shape[2:])


def dir_time_major(u):
    u = jnp.stack([u[:, :, 0], jnp.flip(u[:, :, 1], axis=1)], axis=2)
    return jnp.moveaxis(u, 1, 0)


def dir_time_restore(o):
    o = jnp.moveaxis(o, 0, 1)
    return jnp.stack([o[:, :, 0], jnp.flip(o[:, :, 1], axis=1)], axis=2)


def dir_chunk_major(u):
    u = jnp.stack([u[:, :, 0], jnp.flip(u[:, :, 1], axis=1)], axis=2)
    Bn, T = u.shape[:2]
    u = u.reshape((Bn, T // HGRN_CHUNK, HGRN_CHUNK) + u.shape[2:])
    return jnp.transpose(u, (1, 0, 3, 4, 2, 5))


def dir_chunk_restore(o):
    NC, Bn, _, H, L, Dv = o.shape
    o = jnp.transpose(o, (1, 0, 4, 2, 3, 5)).reshape(Bn, NC * L, 2, H, Dv)
    return jnp.stack([o[:, :, 0], jnp.flip(o[:, :, 1], axis=1)], axis=2)


def rwkv7_step(S, inp):
    r_t, w_t, k_t, v_t, kk_t, a_t = inp
    sa = jnp.einsum('bdhvk,bdhk->bdhv', S, -kk_t)
    S = S * w_t[..., None, :] + sa[..., :, None] * (kk_t * a_t)[..., None, :] + v_t[..., :, None] * k_t[..., None, :]
    return S, jnp.einsum('bdhvk,bdhk->bdhv', S, r_t)


def rwkv7_mix(ua, s0, mu, w0, w2, a0, a2, g2, kk_w, ka_w, r_k, ln_w, ln_b):
    f32 = jnp.float32
    Bn, T, _ = ua.shape
    ua = ua + mu * (centred_shift(ua) - ua)
    r, k, v, glo, wlo, alo = jnp.split(ua, A_SPLITS, axis=-1)
    wlo = wlo.reshape(Bn, T, 2, A_DECAY_RANK)
    alo = alo.reshape(Bn, T, 2, A_ICL_RANK)
    w_logit = w0 + jnp.einsum('btir,irc->btic', jnp.tanh(wlo), w2)
    decay = jnp.exp(-RWKV_DECAY_SCALE * jax.nn.sigmoid(w_logit.astype(f32)))
    a = jax.nn.sigmoid((a0 + jnp.einsum('btir,irc->btic', alo, a2)).astype(f32))
    g = jnp.einsum('btr,rc->btc', jax.nn.sigmoid(glo), g2).astype(f32)

    def heads(u):
        return u.reshape(u.shape[:-1] + (A_HEADS, HEAD_DIM))

    kk = heads((k * kk_w).astype(f32))
    kk = kk / jnp.maximum(jnp.sqrt(jnp.sum(kk * kk, axis=-1, keepdims=True)), 1e-12)
    kd = heads(k.astype(f32)[:, :, None] * (1 + (a - 1) * ka_w.astype(f32)))
    rh = heads(r.astype(f32))
    vh = heads(v.astype(f32))
    xs = (dir_time_major(with_dirs(rh)), dir_time_major(heads(decay)), dir_time_major(kd),
          dir_time_major(with_dirs(vh)), dir_time_major(with_dirs(kk)), dir_time_major(heads(a)))
    s_fin, o = lax.scan(rwkv7_step, s0.astype(f32), xs)
    o = dir_time_restore(o).sum(axis=2)
    mean = jnp.mean(o, axis=-1, keepdims=True)
    var = jnp.mean(jnp.square(o - mean), axis=-1, keepdims=True)
    o = (o - mean) * lax.rsqrt(var + RWKV_GN_EPS) * heads(ln_w.astype(f32)) + heads(ln_b.astype(f32))
    bonus = jnp.sum(rh[:, :, None] * kd * r_k.astype(f32), axis=-1, keepdims=True) * vh[:, :, None]
    o = (o + bonus.sum(axis=2)).reshape(Bn, T, A_WIDTH) * g
    return o.astype(ua.dtype), s_fin


def hgrn2_chunk_step(S, inp):
    q, k, v, lf = inp
    L = lf.shape[-2]
    b = jnp.cumsum(lf, axis=-2)
    causal = jnp.tril(jnp.ones((L, L), dtype=bool))
    rel = jnp.where(causal[:, :, None], b[..., :, None, :] - b[..., None, :, :], -jnp.inf)
    scores = jnp.einsum('bdhtk,bdhsk,bdhtsk->bdhts', q, k, jnp.exp(rel))
    o = jnp.einsum('bdhts,bdhsv->bdhtv', scores, v) + jnp.einsum('bdhtk,bdhkv->bdhtv', q * jnp.exp(b), S)
    b_end = b[..., -1:, :]
    S = jnp.exp(b_end[..., 0, :])[..., :, None] * S + jnp.einsum('bdhsk,bdhsv->bdhkv', k * jnp.exp(b_end - b), v)
    return S, o


def hgrn2_mix(ub, s0, lb, norm_w):
    f32 = jnp.float32
    Bn, T, _ = ub.shape
    q, i, g, f = jnp.split(ub, B_SPLITS, axis=-1)
    f = f.astype(f32).reshape(Bn, T, 2, B_FDIM)
    log_f = jnp.logaddexp(jnp.log(lb), jnp.log1p(-lb) + jax.nn.log_sigmoid(f))
    k = -jnp.expm1(log_f)
    qh = jax.nn.silu(q.astype(f32)).reshape(Bn, T, B_HEADS, B_KDIM)
    vh = i.astype(f32).reshape(Bn, T, B_HEADS, B_VDIM)
    kh = k.reshape(Bn, T, 2, B_HEADS, B_KDIM)
    lfh = log_f.reshape(Bn, T, 2, B_HEADS, B_KDIM)
    xs = (dir_chunk_major(with_dirs(qh)), dir_chunk_major(kh), dir_chunk_major(with_dirs(vh)), dir_chunk_major(lfh))
    s_fin, o = lax.scan(hgrn2_chunk_step, s0.astype(f32), xs)
    o = dir_chunk_restore(o).sum(axis=2)
    o = o * lax.rsqrt(jnp.mean(o * o, axis=-1, keepdims=True) + NORM_EPS) * norm_w.astype(f32).reshape(B_HEADS, B_VDIM)
    o = o.reshape(Bn, T, B_WIDTH) * jax.nn.silu(g.astype(f32))
    return o.astype(ub.dtype), s_fin


def even_mixer(h, s_rwkv0, s_hgrn0, w_in, w_out, mu, w0, w2, a0, a2, g2, kk_w, ka_w, r_k, ln_w, ln_b, lb, hgrn_norm_w):
    u = jnp.einsum('btd,dc->btc', h, w_in)
    oa, sa = rwkv7_mix(u[..., :A_COLS], s_rwkv0, mu, w0, w2, a0, a2, g2, kk_w, ka_w, r_k, ln_w, ln_b)
    ob, sb = hgrn2_mix(u[..., A_COLS:], s_hgrn0, lb, hgrn_norm_w)
    out = jnp.einsum('btc,cd->btd', jnp.concatenate([oa, ob], axis=-1), w_out)
    return out, (sa, sb)


def dense_attend(q, k, v):
    s = jnp.einsum('bqhd,bkhd->bhqk', q, k).astype(jnp.float32) * (q.shape[-1] ** -0.5)
    p = jax.nn.softmax(s, axis=-1).astype(v.dtype)
    return jnp.einsum('bhqk,bkhd->bqhd', p, v)


def diff_attend(q, k, v, lam):
    s = jnp.einsum('bqhid,bkhid->bhiqk', q, k).astype(jnp.float32) * (D_HEAD_DIM ** -0.5)
    p = jax.nn.softmax(s, axis=-1)
    a = (p[:, :, 0] - lam * p[:, :, 1]).astype(v.dtype)
    return jnp.einsum('bhqk,bkhv->bqhv', a, v)


def diff_lambda_value(lam_p, lam_init):
    lp = lam_p.astype(jnp.float32)
    return jnp.exp(jnp.sum(lp[0] * lp[1])) - jnp.exp(jnp.sum(lp[2] * lp[3])) + lam_init


def diff_finish(o, norm_w, lam_init):
    Bn, T = o.shape[:2]
    of = o.astype(jnp.float32)
    of = of * lax.rsqrt(jnp.mean(of * of, axis=-1, keepdims=True) + NORM_EPS) * norm_w.astype(jnp.float32) * (1.0 - lam_init)
    return of.reshape(Bn, T, D_OUT).astype(o.dtype)


def axial_rope_tables(T):
    pos = jnp.arange(T, dtype=jnp.int32)
    grid = jnp.stack([pos // GRID_W, pos % GRID_W], axis=-1).astype(jnp.float32)
    inv_freq = ROPE_BASE ** (-jnp.arange(ROPE_PAIRS, dtype=jnp.float32) / ROPE_PAIRS)
    ang = grid[:, :, None] * inv_freq
    return jnp.cos(ang), jnp.sin(ang)


def axial_rope(x, cos, sin):
    xs = x.astype(jnp.float32).reshape(x.shape[:-1] + (2, 2, ROPE_PAIRS))
    x1, x2 = xs[..., 0, :], xs[..., 1, :]
    c, s = cos[:, None, None], sin[:, None, None]
    out = jnp.stack([x1 * c - x2 * s, x2 * c + x1 * s], axis=-2)
    return out.reshape(x.shape).astype(x.dtype)


def neighbourhood_attend(q, k, v, k_ctx, v_ctx, rpb):
    Bn, T, H, d = q.shape
    rows = T // GRID_W
    kh = min(NA_ROWS, rows)
    scale = d ** -0.5
    r = jnp.arange(rows)
    key_rows = jnp.clip(r - kh // 2, 0, rows - kh)[:, None] + jnp.arange(kh)[None, :]

    def grid(t):
        return t.reshape(Bn, rows, GRID_W, H, d)

    qg = grid(q)
    kg = grid(k)[:, key_rows]
    vg = grid(v)[:, key_rows].reshape(Bn, rows, kh * GRID_W, H, d)
    col = jnp.arange(GRID_W)
    c0 = jnp.clip(col - NA_COLS // 2, 0, GRID_W - NA_COLS)
    col_ok = (col[None, :] >= c0[:, None]) & (col[None, :] < c0[:, None] + NA_COLS)
    dr = key_rows - r[:, None] + (NA_ROWS - 1)
    dc = jnp.clip(col[None, :] - col[:, None] + (NA_COLS - 1), 0, 2 * NA_COLS - 2)
    bias = rpb[:, dr[:, None, :, None], dc[None, :, None, :]].astype(jnp.float32)
    s_win = jnp.einsum('brqhd,brjkhd->bhrqjk', qg, kg).astype(jnp.float32) * scale + bias
    s_win = jnp.where(col_ok[:, None, :], s_win, -jnp.inf).reshape(Bn, H, rows, GRID_W, kh * GRID_W)
    s_ctx = jnp.einsum('brqhd,bphd->bhrqp', qg, k_ctx).astype(jnp.float32) * scale
    p = jax.nn.softmax(jnp.concatenate([s_win, s_ctx], axis=-1), axis=-1).astype(v.dtype)
    nw = kh * GRID_W
    o = jnp.einsum('bhrqj,brjhd->brqhd', p[..., :nw], vg) + jnp.einsum('bhrqp,bphd->brqhd', p[..., nw:], v_ctx)
    return o.reshape(Bn, T, H, d)


def odd_context_mixer(h, w_in, w_out, diff_lam, diff_norm_w, lam_init):
    Bn, T, _ = h.shape
    u = jnp.einsum('btd,dc->btc', h, w_in)
    qc, kc, vc, qd, kd, vd = jnp.split(u, ODD_SPLITS, axis=-1)
    kc = kc.reshape(Bn, T, C_HEADS, HEAD_DIM)
    vc = vc.reshape(Bn, T, C_HEADS, HEAD_DIM)
    oc = dense_attend(qc.reshape(Bn, T, C_HEADS, HEAD_DIM), kc, vc)
    kd = kd.reshape(Bn, T, D_HEADS, 2, D_HEAD_DIM)
    vd = vd.reshape(Bn, T, D_HEADS, D_V_DIM)
    lam = diff_lambda_value(diff_lam, lam_init)
    od = diff_finish(diff_attend(qd.reshape(Bn, T, D_HEADS, 2, D_HEAD_DIM), kd, vd, lam), diff_norm_w, lam_init)
    out = jnp.einsum('btc,cd->btd', jnp.concatenate([oc.reshape(Bn, T, C_WIDTH), od], axis=-1), w_out)
    return out, (kc, vc, kd.reshape(Bn, T, D_HEADS, 2 * D_HEAD_DIM), vd)


def odd_latent_mixer(h, k_nat_ctx, v_nat_ctx, k_diff_ctx, v_diff_ctx, w_in, w_out, rpb, diff_lam, diff_norm_w, lam_init):
    Bn, T, _ = h.shape
    P = k_nat_ctx.shape[1]
    u = jnp.einsum('btd,dc->btc', h, w_in)
    qc, kc, vc, qd, kd, vd = jnp.split(u, ODD_SPLITS, axis=-1)
    oc = neighbourhood_attend(qc.reshape(Bn, T, C_HEADS, HEAD_DIM), kc.reshape(Bn, T, C_HEADS, HEAD_DIM),
                              vc.reshape(Bn, T, C_HEADS, HEAD_DIM), k_nat_ctx, v_nat_ctx, rpb)
    cos, sin = axial_rope_tables(T)
    qd = axial_rope(qd.reshape(Bn, T, D_HEADS, 2, D_HEAD_DIM), cos, sin)
    kd = axial_rope(kd.reshape(Bn, T, D_HEADS, 2, D_HEAD_DIM), cos, sin)
    k_all = jnp.concatenate([kd, k_diff_ctx.reshape(Bn, P, D_HEADS, 2, D_HEAD_DIM).astype(kd.dtype)], axis=1)
    v_all = jnp.concatenate([vd.reshape(Bn, T, D_HEADS, D_V_DIM), v_diff_ctx.astype(vd.dtype)], axis=1)
    lam = diff_lambda_value(diff_lam, lam_init)
    nb = T // Q_BLOCK
    qb = jnp.moveaxis(qd.reshape(Bn, nb, Q_BLOCK, D_HEADS, 2, D_HEAD_DIM), 1, 0)
    ob = lax.map(lambda qblk: diff_attend(qblk, k_all, v_all, lam), qb)
    od = diff_finish(jnp.moveaxis(ob, 0, 1).reshape(Bn, T, D_HEADS, D_V_DIM), diff_norm_w, lam_init)
    out = jnp.einsum('btc,cd->btd', jnp.concatenate([oc.reshape(Bn, T, C_WIDTH), od], axis=-1), w_out)
    return out, ()


def setup_inputs(seed: int = 0) -> dict:
    key = jax.random.key(seed)
    ks = iter(jax.random.split(key, 40))
    D = D_MODEL

    def nrm(shape, scale):
        return scale * jax.random.normal(next(ks), shape, jnp.float32)

    def gain(shape):
        return 1.0 + nrm(shape, 0.02)

    return {
        'x_prompt': nrm((BATCH, SEQ, D), 1.0),
        'x_sample': nrm((DEC_BATCH, DEC_SEQ, D), 1.0),
        'c': nrm((DEC_BATCH, D), 1.0),
        'state_rwkv': nrm((DEC_BATCH, N_EVEN, 2, A_HEADS, HEAD_DIM, HEAD_DIM), 0.5),
        'state_hgrn': nrm((DEC_BATCH, N_EVEN, 2, B_HEADS, B_KDIM, B_VDIM), 0.5),
        'cache_nat_k': nrm((DEC_BATCH, N_ODD, PAST_LEN, C_HEADS, HEAD_DIM), 1.0),
        'cache_nat_v': nrm((DEC_BATCH, N_ODD, PAST_LEN, C_HEADS, HEAD_DIM), 1.0),
        'cache_diff_k': nrm((DEC_BATCH, N_ODD, PAST_LEN, D_HEADS, 2 * D_HEAD_DIM), 1.0),
        'cache_diff_v': nrm((DEC_BATCH, N_ODD, PAST_LEN, D_HEADS, D_V_DIM), 1.0),
        'c_ctx': nrm((D,), 1.0),
        'ada_w': nrm((DEPTH, D, N_MOD * D), 0.5 * D ** -0.5),
        'ada_b': nrm((DEPTH, N_MOD * D), 0.02),
        'norm_w': gain((DEPTH, 6, D)),
        'ffn_w1': nrm((DEPTH, 2, D, 2 * D_FF), D ** -0.5),
        'ffn_w2': nrm((DEPTH, 2, D_FF, D), D_FF ** -0.5),
        'ev_w_in': nrm((N_EVEN, D, EVEN_COLS), D ** -0.5),
        'ev_w_out': nrm((N_EVEN, A_WIDTH + B_WIDTH, D), (A_WIDTH + B_WIDTH) ** -0.5),
        'rwkv_mu': jax.random.uniform(next(ks), (N_EVEN, A_COLS), jnp.float32),
        'rwkv_w0': nrm((N_EVEN, 2, A_WIDTH), 0.5),
        'rwkv_w2': nrm((N_EVEN, 2, A_DECAY_RANK, A_WIDTH), A_DECAY_RANK ** -0.5),
        'rwkv_a0': nrm((N_EVEN, 2, A_WIDTH), 0.1),
        'rwkv_a2': nrm((N_EVEN, 2, A_ICL_RANK, A_WIDTH), A_ICL_RANK ** -0.5),
        'rwkv_g2': nrm((N_EVEN, A_GATE_RANK, A_WIDTH), A_GATE_RANK ** -0.5),
        'rwkv_kk': gain((N_EVEN, A_WIDTH)),
        'rwkv_ka': gain((N_EVEN, A_WIDTH)),
        'rwkv_rk': nrm((N_EVEN, A_HEADS, HEAD_DIM), 0.1),
        'rwkv_ln_w': gain((N_EVEN, A_WIDTH)),
        'rwkv_ln_b': nrm((N_EVEN, A_WIDTH), 0.02),
        'hgrn_lb': nrm((N_EVEN, 2, B_FDIM), 0.5),
        'hgrn_norm_w': gain((N_EVEN, B_WIDTH)),
        'od_w_in': nrm((N_ODD, D, ODD_COLS), D ** -0.5),
        'od_w_out': nrm((N_ODD, C_WIDTH + D_OUT, D), (C_WIDTH + D_OUT) ** -0.5),
        'nat_rpb': nrm((N_ODD, C_HEADS, 2 * NA_ROWS - 1, 2 * NA_COLS - 1), 0.02),
        'diff_lambda': nrm((N_ODD, 4, D_HEAD_DIM), 0.1),
        'diff_norm_w': gain((N_ODD, D_V_DIM)),
    }


def reference(x_prompt, x_sample, c, state_rwkv, state_hgrn, cache_nat_k, cache_nat_v, cache_diff_k, cache_diff_v,
              c_ctx, ada_w, ada_b, norm_w, ffn_w1, ffn_w2, ev_w_in, ev_w_out, rwkv_mu, rwkv_w0, rwkv_w2, rwkv_a0,
              rwkv_a2, rwkv_g2, rwkv_kk, rwkv_ka, rwkv_rk, rwkv_ln_w, rwkv_ln_b, hgrn_lb, hgrn_norm_w, od_w_in,
              od_w_out, nat_rpb, diff_lambda, diff_norm_w):
    f32 = jnp.float32
    bp = x_prompt.shape[0]
    lb_all = jnp.cumsum(jax.nn.softmax(hgrn_lb.astype(f32), axis=0), axis=0)
    lb_all = lb_all - lb_all[0:1]
    xp, xs = x_prompt, x_sample
    new_rwkv, new_hgrn, new_nk, new_nv, new_dk, new_dv = [], [], [], [], [], []
    for l in range(DEPTH):
        li = l // 2
        m_ctx = adaln_mod(c_ctx[None], ada_w[l], ada_b[l])
        m_lat = adaln_mod(c, ada_w[l], ada_b[l])
        if l % 2 == 0:
            ev = functools.partial(even_mixer, w_in=ev_w_in[li], w_out=ev_w_out[li], mu=rwkv_mu[li], w0=rwkv_w0[li],
                                   w2=rwkv_w2[li], a0=rwkv_a0[li], a2=rwkv_a2[li], g2=rwkv_g2[li], kk_w=rwkv_kk[li],
                                   ka_w=rwkv_ka[li], r_k=rwkv_rk[li], ln_w=rwkv_ln_w[li], ln_b=rwkv_ln_b[li],
                                   lb=lb_all[li], hgrn_norm_w=hgrn_norm_w[li])
            zr = jnp.zeros((bp, 2, A_HEADS, HEAD_DIM, HEAD_DIM), f32)
            zh = jnp.zeros((bp, 2, B_HEADS, B_KDIM, B_VDIM), f32)
            xp, (sr, sh) = sandwich_layer(xp, m_ctx, norm_w[l], ffn_w1[l], ffn_w2[l],
                                          functools.partial(ev, s_rwkv0=zr, s_hgrn0=zh))
            xs, _ = sandwich_layer(xs, m_lat, norm_w[l], ffn_w1[l], ffn_w2[l],
                                   functools.partial(ev, s_rwkv0=state_rwkv[:, li], s_hgrn0=state_hgrn[:, li]))
            new_rwkv.append(sr)
            new_hgrn.append(sh)
        else:
            lam_init = 0.8 - 0.6 * math.exp(-0.3 * l)
            xp, (kc, vc, kd, vd) = sandwich_layer(
                xp, m_ctx, norm_w[l], ffn_w1[l], ffn_w2[l],
                functools.partial(odd_context_mixer, w_in=od_w_in[li], w_out=od_w_out[li], diff_lam=diff_lambda[li],
                                  diff_norm_w=diff_norm_w[li], lam_init=lam_init))
            xs, _ = sandwich_layer(
                xs, m_lat, norm_w[l], ffn_w1[l], ffn_w2[l],
                functools.partial(odd_latent_mixer, k_nat_ctx=cache_nat_k[:, li], v_nat_ctx=cache_nat_v[:, li],
                                  k_diff_ctx=cache_diff_k[:, li], v_diff_ctx=cache_diff_v[:, li], w_in=od_w_in[li],
                                  w_out=od_w_out[li], rpb=nat_rpb[li], diff_lam=diff_lambda[li],
                                  diff_norm_w=diff_norm_w[li], lam_init=lam_init))
            new_nk.append(kc)
            new_nv.append(vc)
            new_dk.append(kd)
            new_dv.append(vd)
    return (xp, xs, jnp.stack(new_rwkv, axis=1), jnp.stack(new_hgrn, axis=1), jnp.stack(new_nk, axis=1),
            jnp.stack(new_nv, axis=1), jnp.stack(new_dk, axis=1), jnp.stack(new_dv, axis=1))
```

```cpp
#include <hip/hip_runtime.h>
#include <cstdio>
#include <cstdint>

namespace pg8 {
#define PG8_LAS __attribute__((address_space(3)))
typedef unsigned short bf16_t;
typedef short bf16x8 __attribute__((ext_vector_type(8)));
typedef float f32x4 __attribute__((ext_vector_type(4)));
typedef unsigned u32x4 __attribute__((ext_vector_type(4)));
constexpr int BM = 256, BK = 64, HALF = 128, HTB = HALF * BK * 2, STAGE_BYTES = 8 * HTB, NXCD = 8, WGM = 4;

__host__ __device__ __forceinline__ int lds_byte(int r, int c) { const int st = (r >> 4) * 2 + (c >> 5), rr = r & 15, cc = c & 31, ob = rr * 64 + cc * 2; return st * 1024 + (ob ^ (((ob >> 9) & 1) << 5)); }
__host__ __device__ __forceinline__ void stage_rc(int b, int& R, int& C) { const int st = b / 1024, sb = b % 1024, swz = sb ^ (((sb >> 9) & 1) << 5); R = (st >> 1) * 16 + swz / 64; C = (st & 1) * 32 + (swz % 64) / 2; }
__host__ __device__ __forceinline__ int perm32(int rho) { const int n = rho >> 4, i = rho & 15; return 8 * (i >> 2) + 4 * n + (i & 3); }

struct Unit { int pm, pn, ks; };
struct Gemm { const bf16_t* A; const bf16_t* Bt; int M, N, K, kb1; };
__device__ __forceinline__ int unit_kbeg(const Gemm& g, const Unit& u) { return g.kb1 < 0 ? 128 * (u.pn >> 2) : (u.ks ? g.kb1 : 0); }
__device__ __forceinline__ int unit_nt(const Gemm& g, const Unit& u) { return g.kb1 < 0 ? (((u.pn >> 2) == 4) ? 4 : 2) : ((u.ks ? (g.K - g.kb1) : g.kb1) / BK); }

struct StaticOrder {
    int nM, nN, nwg, G, c, nN0;
    __host__ __device__ void init(int M, int N, int G_, int c_, int nsplit = 1) { nM = M / BM; nN0 = N / BM; nN = nN0 * nsplit; nwg = nM * nN; G = G_; c = c_; }
    __host__ __device__ bool next(int i, Unit& u) const {
        const long L = (long)i * G + c; if (L >= nwg) return false;
        int wgid = (int)L; { const int q = nwg / NXCD, r = nwg % NXCD, xcd = wgid % NXCD, off = wgid / NXCD; wgid = (xcd < r ? xcd * (q + 1) : r * (q + 1) + (xcd - r) * q) + off; }
        const int nig = WGM * nN, gid = wgid / nig, fm = gid * WGM, gsz = (nM - fm) < WGM ? (nM - fm) : WGM;
        u.pm = fm + ((wgid % nig) % gsz); const int pne = (wgid % nig) / gsz; u.ks = pne / nN0; u.pn = pne - u.ks * nN0; return true;
    }
    __device__ __forceinline__ void a_ready(const Unit&) const {}
    __device__ __forceinline__ void done(const Unit&) const {}
};

__device__ __forceinline__ unsigned cvt_pk_bf16(float lo, float hi) { unsigned r; asm volatile("v_cvt_pk_bf16_f32 %0, %1, %2" : "=v"(r) : "v"(lo), "v"(hi)); return r; }

struct EpiF32 {
    static constexpr bool PERM = false, AFTER_DRAIN = false;
    float* C; int ldc;
    __device__ __forceinline__ void operator()(const f32x4 (&acc)[2][2][4][2], const Unit& u, int wr, int wc, int fr, int fq) const {
        const int row0 = u.pm * BM + wr * 64 + fr, col0 = u.pn * BM + wc * 32 + 4 * fq;
#pragma unroll
        for (int ai = 0; ai < 2; ++ai)
#pragma unroll
            for (int m = 0; m < 4; ++m) { float* rowp = C + (size_t)(row0 + ai * HALF + m * 16) * ldc + col0;
#pragma unroll
                for (int bj = 0; bj < 2; ++bj)
#pragma unroll
                    for (int n = 0; n < 2; ++n) *(f32x4*)(rowp + bj * HALF + n * 16) = acc[ai][bj][m][n]; }
    }
};
struct EpiSlab {
    static constexpr bool PERM = true, AFTER_DRAIN = false;
    bf16_t* O; int ldc; size_t slab;
    __device__ __forceinline__ void operator()(const f32x4 (&acc)[2][2][4][2], const Unit& u, int wr, int wc, int fr, int fq) const {
        const int row0 = u.pm * BM + wr * 64 + fr, col0 = u.pn * BM + wc * 32 + 8 * fq;
        bf16_t* base = O + (u.ks ? slab : 0);
#pragma unroll
        for (int ai = 0; ai < 2; ++ai)
#pragma unroll
            for (int m = 0; m < 4; ++m) { bf16_t* rowp = base + (size_t)(row0 + ai * HALF + m * 16) * ldc + col0;
#pragma unroll
                for (int bj = 0; bj < 2; ++bj) { const f32x4 v0 = acc[ai][bj][m][0], v1 = acc[ai][bj][m][1];
                    u32x4 w; w.x = cvt_pk_bf16(v0[0], v0[1]); w.y = cvt_pk_bf16(v0[2], v0[3]); w.z = cvt_pk_bf16(v1[0], v1[1]); w.w = cvt_pk_bf16(v1[2], v1[3]);
                    *(u32x4*)(rowp + bj * HALF) = w; } }
    }
};
struct EpiSwiglu {
    static constexpr bool PERM = true, AFTER_DRAIN = false;
    bf16_t* O; int ldc;
    __device__ __forceinline__ void operator()(const f32x4 (&acc)[2][2][4][2], const Unit& u, int wr, int wc, int fr, int fq) const {
        const int row0 = u.pm * BM + wr * 64 + fr, col0 = u.pn * HALF + wc * 32 + 8 * fq;
#pragma unroll
        for (int ai = 0; ai < 2; ++ai)
#pragma unroll
            for (int m = 0; m < 4; ++m) { bf16_t* rowp = O + (size_t)(row0 + ai * HALF + m * 16) * ldc + col0;
                float r[8];
#pragma unroll
                for (int n = 0; n < 2; ++n)
#pragma unroll
                    for (int j = 0; j < 4; ++j) { const float g = acc[ai][0][m][n][j], up = acc[ai][1][m][n][j];
                        r[n * 4 + j] = g * __builtin_amdgcn_rcpf(1.0f + __expf(-g)) * up; }
                u32x4 w; w.x = cvt_pk_bf16(r[0], r[1]); w.y = cvt_pk_bf16(r[2], r[3]); w.z = cvt_pk_bf16(r[4], r[5]); w.w = cvt_pk_bf16(r[6], r[7]);
                *(u32x4*)rowp = w; }
    }
};

struct EpiOdd {
    static constexpr bool PERM = false, AFTER_DRAIN = false;
    bf16_t* UB; const float* rope; float* onk; float* onv; float* odk; float* odv; int li; float qscale;
    __device__ __forceinline__ void operator()(const f32x4 (&acc)[2][2][4][2], const Unit& u, int wr, int wc, int fr, int fq) const {
        const int colt = u.pn * BM, type = colt >> 10;
        const bool smp = u.pm >= 32, dorope = smp && (type == 3 || type == 4);
        const float sc = (type == 0 || type == 3) ? qscale : 1.0f;
        float* fo = smp ? nullptr : (type == 1 ? onk : type == 2 ? onv : type == 4 ? odk : type == 5 ? odv : nullptr);
        const int row0 = u.pm * BM + wr * 64 + fr, col0 = colt + wc * 32 + 4 * fq;
#pragma unroll
        for (int ai = 0; ai < 2; ++ai)
#pragma unroll
            for (int m = 0; m < 4; ++m) {
                const int r = row0 + ai * HALF + m * 16;
                f32x4 cs0 = {1.f, 0.f, 1.f, 0.f}, cs1 = cs0;
                if (dorope) { const int t = (r - 8192) & 2047; const int pos = (wc & 1) ? (t & 63) : (t >> 6); const float* tb = rope + (pos * 16 + 4 * fq) * 2; cs0 = *(const f32x4*)tb; cs1 = *(const f32x4*)(tb + 4); }
                const size_t orow = ((size_t)((r >> 8) * 2 + li) * 256 + (r & 255)) * 1024;
#pragma unroll
                for (int bj = 0; bj < 2; ++bj) {
                    f32x4 v0 = acc[ai][bj][m][0], v1 = acc[ai][bj][m][1];
                    const int c = col0 + bj * HALF;
                    if (fo) { *(f32x4*)(fo + orow + (c & 1023)) = v0; *(f32x4*)(fo + orow + ((c + 16) & 1023)) = v1; }
                    if (dorope) {
                        f32x4 a, b;
                        a.x = v0.x * cs0.x - v1.x * cs0.y; b.x = v1.x * cs0.x + v0.x * cs0.y;
                        a.y = v0.y * cs0.z - v1.y * cs0.w; b.y = v1.y * cs0.z + v0.y * cs0.w;
                        a.z = v0.z * cs1.x - v1.z * cs1.y; b.z = v1.z * cs1.x + v0.z * cs1.y;
                        a.w = v0.w * cs1.z - v1.w * cs1.w; b.w = v1.w * cs1.z + v0.w * cs1.w;
                        v0 = a; v1 = b;
                    }
                    v0 = v0 * sc; v1 = v1 * sc;
                    bf16_t* dp = UB + (size_t)r * 6144 + c;
                    typedef unsigned u32x2 __attribute__((ext_vector_type(2)));
                    u32x2 w0, w1; w0.x = cvt_pk_bf16(v0.x, v0.y); w0.y = cvt_pk_bf16(v0.z, v0.w); w1.x = cvt_pk_bf16(v1.x, v1.y); w1.y = cvt_pk_bf16(v1.z, v1.w);
                    *(u32x2*)dp = w0; *(u32x2*)(dp + 16) = w1;
                }
            }
    }
};

template <class Epi, class Sched, bool ALIGN_EPI = false, bool SP2 = false>
__device__ __forceinline__ void gemm_phase(PG8_LAS unsigned char* lds, const Gemm g, const Sched& S, const Epi& E, const int tid) {
    const int wid = __builtin_amdgcn_readfirstlane(tid >> 6), lane = tid & 63, wr = wid >> 2, wc = wid & 3, fr = lane & 15, fq = lane >> 4;
    const int K = g.K;
    unsigned voffA[2], voffB[2];
#pragma unroll
    for (int i = 0; i < 2; ++i) { int R, C; stage_rc(tid * 16 + i * 8192, R, C); const int Rb = Epi::PERM ? ((R & ~31) + perm32(R & 31)) : R;
        voffA[i] = (unsigned)(R * K + C) * 2u; voffB[i] = (unsigned)(Rb * K + C) * 2u; }
    const size_t kstep = (size_t)(BK * 2);
    const size_t hstep = (size_t)HALF * K * 2;
    const size_t tstep = 2 * hstep;
    const unsigned ldsw = (unsigned)wid * 1024u;
    const int aoff = lds_byte(wr * 64 + fr, fq * 8), boff = lds_byte(wc * 32 + fr, fq * 8);
#define PG8_SA(b, h) (((b) * 2 + (h)) * HTB)
#define PG8_SB(b, h) ((4 + (b) * 2 + (h)) * HTB)
#define PG8_STAGE(bufoff, gbase, voff) do { _Pragma("unroll") for (int _i = 0; _i < 2; ++_i) \
        __builtin_amdgcn_global_load_lds((const unsigned*)((const char*)(gbase) + (voff)[_i]), (PG8_LAS unsigned*)(lds + (bufoff) + ldsw + _i * 8192), 16, 0, 0); } while (0)
#define PG8_LDA(dst, b, h) do { _Pragma("unroll") for (int m = 0; m < 4; ++m) _Pragma("unroll") for (int k = 0; k < 2; ++k) dst[m][k] = *(const PG8_LAS bf16x8*)(lds + PG8_SA(b, h) + aoff + m * 2048 + k * 1024); } while (0)
#define PG8_LDB(dst, b, h) do { _Pragma("unroll") for (int n = 0; n < 2; ++n) _Pragma("unroll") for (int k = 0; k < 2; ++k) dst[n][k] = *(const PG8_LAS bf16x8*)(lds + PG8_SB(b, h) + boff + n * 2048 + k * 1024); } while (0)
#define PG8_MMA(ai, bj, At, Bt) do { __builtin_amdgcn_s_setprio(1); _Pragma("unroll") for (int m = 0; m < 4; ++m) _Pragma("unroll") for (int n = 0; n < 2; ++n) _Pragma("unroll") for (int k = 0; k < 2; ++k) \
        acc[ai][bj][m][n] = __builtin_amdgcn_mfma_f32_16x16x32_bf16(Bt[n][k], At[m][k], acc[ai][bj][m][n], 0, 0, 0); __builtin_amdgcn_s_setprio(0); } while (0)
#define PG8_WAIT_V(n) asm volatile("s_waitcnt vmcnt(" #n ")" ::: "memory")
#define PG8_WAIT_L(n) asm volatile("s_waitcnt lgkmcnt(" #n ")" ::: "memory")
#define PG8_BAR __builtin_amdgcn_s_barrier()
#define PG8_SCHED __builtin_amdgcn_sched_barrier(0)
    Unit cur, nxt; int ui = 0;
    if (!S.next(0, cur)) return;
    f32x4 acc[2][2][4][2];
#pragma unroll
    for (int a = 0; a < 2; ++a)
#pragma unroll
        for (int b = 0; b < 2; ++b)
#pragma unroll
            for (int m = 0; m < 4; ++m)
#pragma unroll
                for (int n = 0; n < 2; ++n) acc[a][b][m][n] = (f32x4){0.f, 0.f, 0.f, 0.f};
    bf16x8 At[4][2], B0[2][2], B1[2][2];
    const char* cA = (const char*)g.A + (size_t)cur.pm * tstep + (size_t)unit_kbeg(g, cur) * 2; const char* cB = (const char*)g.Bt + (size_t)cur.pn * tstep + (size_t)unit_kbeg(g, cur) * 2;
    int nt = unit_nt(g, cur);
    S.a_ready(cur);
    if constexpr (SP2) {
        PG8_STAGE(PG8_SB(0, 0), cB, voffB); PG8_STAGE(PG8_SB(0, 1), cB + hstep, voffB); PG8_STAGE(PG8_SA(0, 0), cA, voffA); PG8_STAGE(PG8_SA(0, 1), cA + hstep, voffA);
        if (wr == 1) PG8_BAR;
        PG8_WAIT_V(2); PG8_BAR;
        PG8_STAGE(PG8_SB(1, 0), cB + kstep, voffB); PG8_STAGE(PG8_SA(1, 0), cA + kstep, voffA); PG8_STAGE(PG8_SB(1, 1), cB + hstep + kstep, voffB);
        PG8_WAIT_V(6); PG8_BAR;
    } else {
        PG8_STAGE(PG8_SB(0, 0), cB, voffB); PG8_STAGE(PG8_SA(0, 0), cA, voffA); PG8_STAGE(PG8_SB(0, 1), cB + hstep, voffB); PG8_STAGE(PG8_SA(0, 1), cA + hstep, voffA);
        if (wr == 1) PG8_BAR;
        PG8_WAIT_V(4); PG8_BAR;
        PG8_STAGE(PG8_SB(1, 0), cB + kstep, voffB); PG8_STAGE(PG8_SA(1, 0), cA + kstep, voffA); PG8_STAGE(PG8_SB(1, 1), cB + hstep + kstep, voffB);
        PG8_WAIT_V(6); PG8_BAR;
    }
    for (;;) {
        const bool has_next = S.next(ui + 1, nxt);
        const size_t nko = has_next ? (size_t)unit_kbeg(g, nxt) * 2 : 0;
        const char* nA = has_next ? (const char*)g.A + (size_t)nxt.pm * tstep + nko : cA; const char* nB = has_next ? (const char*)g.Bt + (size_t)nxt.pn * tstep + nko : cB;
        for (int t = 0; t < nt; t += 2) {
            const bool last = (t == nt - 2);
            const char* a1 = cA + (size_t)(t + 1) * kstep;
            const char* a2 = last ? nA : cA + (size_t)(t + 2) * kstep; const char* b2 = last ? nB : cB + (size_t)(t + 2) * kstep;
            const char* a3 = a2 + kstep; const char* b3 = b2 + kstep;
            if (last && has_next) S.a_ready(nxt);
            if constexpr (SP2) {
            PG8_LDB(B0, 0, 0); PG8_LDB(B1, 0, 1); PG8_SCHED; PG8_LDA(At, 0, 0); PG8_STAGE(PG8_SA(1, 1), a1 + hstep, voffA);
            PG8_WAIT_V(8); PG8_WAIT_L(0); PG8_BAR; PG8_MMA(0, 0, At, B0); PG8_MMA(0, 1, At, B1); PG8_BAR; PG8_SCHED;
            PG8_LDA(At, 0, 1); PG8_STAGE(PG8_SB(0, 0), b2, voffB); PG8_STAGE(PG8_SB(0, 1), b2 + hstep, voffB); PG8_STAGE(PG8_SA(0, 0), a2, voffA);
            PG8_WAIT_V(8); PG8_WAIT_L(0); PG8_BAR; PG8_MMA(1, 0, At, B0); PG8_MMA(1, 1, At, B1); PG8_BAR; PG8_SCHED;
            PG8_LDB(B0, 1, 0); PG8_LDB(B1, 1, 1); PG8_SCHED; PG8_LDA(At, 1, 0); PG8_STAGE(PG8_SA(0, 1), a2 + hstep, voffA);
            PG8_WAIT_V(8); PG8_WAIT_L(0); PG8_BAR; PG8_MMA(0, 0, At, B0); PG8_MMA(0, 1, At, B1); PG8_BAR; PG8_SCHED;
            PG8_LDA(At, 1, 1); PG8_STAGE(PG8_SB(1, 0), b3, voffB); PG8_STAGE(PG8_SB(1, 1), b3 + hstep, voffB); PG8_STAGE(PG8_SA(1, 0), a3, voffA);
            PG8_WAIT_V(8); PG8_WAIT_L(0); PG8_BAR; PG8_MMA(1, 0, At, B0); PG8_MMA(1, 1, At, B1); PG8_BAR; PG8_SCHED;
            } else {
            PG8_LDB(B0, 0, 0); PG8_SCHED; PG8_LDA(At, 0, 0); PG8_STAGE(PG8_SA(1, 1), a1 + hstep, voffA);
            PG8_WAIT_L(8); PG8_BAR; PG8_WAIT_L(0); PG8_MMA(0, 0, At, B0); PG8_BAR; PG8_SCHED;
            PG8_LDB(B1, 0, 1); PG8_STAGE(PG8_SB(0, 0), b2, voffB);
            PG8_BAR; PG8_WAIT_L(0); PG8_MMA(0, 1, At, B1); PG8_BAR;
            PG8_LDA(At, 0, 1); PG8_STAGE(PG8_SA(0, 0), a2, voffA);
            PG8_BAR; PG8_WAIT_L(0); PG8_MMA(1, 0, At, B0); PG8_BAR; PG8_SCHED;
            PG8_STAGE(PG8_SB(0, 1), b2 + hstep, voffB);
            PG8_WAIT_V(6); PG8_BAR; PG8_MMA(1, 1, At, B1); PG8_BAR;
            PG8_LDB(B0, 1, 0); PG8_SCHED; PG8_LDA(At, 1, 0); PG8_STAGE(PG8_SA(0, 1), a2 + hstep, voffA);
            PG8_WAIT_L(8); PG8_BAR; PG8_WAIT_L(0); PG8_MMA(0, 0, At, B0); PG8_BAR; PG8_SCHED;
            PG8_LDB(B1, 1, 1); PG8_STAGE(PG8_SB(1, 0), b3, voffB);
            PG8_BAR; PG8_WAIT_L(0); PG8_MMA(0, 1, At, B1); PG8_BAR;
            PG8_LDA(At, 1, 1); PG8_STAGE(PG8_SA(1, 0), a3, voffA);
            PG8_BAR; PG8_WAIT_L(0); PG8_MMA(1, 0, At, B0); PG8_BAR; PG8_SCHED;
            PG8_STAGE(PG8_SB(1, 1), b3 + hstep, voffB);
            PG8_WAIT_V(6); PG8_BAR; PG8_MMA(1, 1, At, B1); PG8_BAR;
            }
        }
        if constexpr (ALIGN_EPI) { if (wr == 0) PG8_BAR; }
        if constexpr (!Epi::AFTER_DRAIN) { E(acc, cur, wr, wc, fr, fq); S.done(cur); }
        if (!has_next) break;
#pragma unroll
        for (int a = 0; a < 2; ++a)
#pragma unroll
            for (int b = 0; b < 2; ++b)
#pragma unroll
                for (int m = 0; m < 4; ++m)
#pragma unroll
                    for (int n = 0; n < 2; ++n) acc[a][b][m][n] = (f32x4){0.f, 0.f, 0.f, 0.f};
        cur = nxt; cA = nA; cB = nB; ++ui; nt = unit_nt(g, cur);
        if constexpr (ALIGN_EPI) { if (wr == 1) PG8_BAR; }
    }
    PG8_WAIT_V(0);
    if constexpr (!ALIGN_EPI) { if (wr == 0) PG8_BAR; }
    PG8_BAR;
#undef PG8_SA
#undef PG8_SB
#undef PG8_STAGE
#undef PG8_LDA
#undef PG8_LDB
#undef PG8_MMA
#undef PG8_WAIT_V
#undef PG8_WAIT_L
#undef PG8_BAR
#undef PG8_SCHED
}
}

constexpr int D = 2048, MP = 8192, MS = 4096, M = MP + MS;
constexpr int FF = 5504, NF1 = 2 * FF;
constexpr int EVC = 8608, EVP = 8704, ODC = 6144, ACOLS = 3488;
constexpr int NMOD = 9 * D;
constexpr int LK = 768;
constexpr int NWAVES = 8, NTHR = 512;
constexpr float NORM_EPS = 1e-6f;
constexpr float LOG2E = 1.4426950408889634f;

constexpr size_t MiB = 1u << 20;
constexpr size_t WS_CTL = 0, CTL_ZERO_BYTES = 64 * 1024;
constexpr size_t WS_PAR   = 64 * 1024;
constexpr size_t WS_PTRS  = 512 * 1024;
constexpr size_t WS_MOD   = 1 * MiB;
constexpr size_t WS_ROPE  = WS_MOD + 960 * 1024;
constexpr size_t WS_W1T   = 2 * MiB;
constexpr size_t WS_W2T   = WS_W1T + 344 * MiB;
constexpr size_t WS_EVIN  = WS_W2T + 172 * MiB;
constexpr size_t WS_ODIN  = WS_EVIN + 68 * MiB;
constexpr size_t WS_EVOUT = WS_ODIN + 48 * MiB;
constexpr size_t WS_ODOUT = WS_EVOUT + 16 * MiB;
constexpr size_t WS_LRW   = WS_ODOUT + 16 * MiB;
constexpr size_t WS_CCH   = WS_LRW + 16 * MiB;
constexpr size_t WS_X     = WS_CCH + 8 * MiB;
constexpr size_t WS_H     = WS_X + 96 * MiB;
constexpr size_t WS_ACT   = WS_H + 48 * MiB;
constexpr size_t WS_Y     = WS_ACT + 130 * MiB;
constexpr size_t WS_U     = WS_Y + 96 * MiB;
constexpr size_t WS_MIXO  = WS_U + 408 * MiB;
constexpr size_t WS_SCR   = WS_MIXO + 48 * MiB;
constexpr size_t A48 = (size_t)M * 1024 * 4;
constexpr size_t WS_L     = WS_SCR;
constexpr size_t WS_LR    = WS_L + 18 * MiB;
constexpr size_t WS_RWR   = WS_LR + 240 * MiB;
constexpr size_t WS_RWV   = WS_RWR + A48;
constexpr size_t WS_RWKK  = WS_RWV + A48;
constexpr size_t WS_RWW   = WS_RWKK + A48;
constexpr size_t WS_RWKD  = WS_RWW + 2 * A48;
constexpr size_t WS_RWB   = WS_RWKD + 2 * A48;
constexpr size_t WS_BONUS = WS_RWB + 2 * A48;
constexpr size_t WS_HQ    = WS_BONUS + 1 * MiB;
constexpr size_t WS_HF    = WS_HQ + A48;
constexpr size_t WS_RWO   = WS_HF + 2 * A48;
constexpr size_t WS_HGO   = WS_RWO + 2 * A48;
constexpr size_t WS_EVEN_END = WS_HGO + 2 * A48;
constexpr size_t WS_UB    = WS_SCR;
constexpr size_t WS_END   = WS_EVEN_END;
static_assert(WS_UB + (size_t)M * 6144 * 2 <= WS_END, "odd scratch inside even scratch");

constexpr size_t OUT_Y = 0, OUT_SRW = (size_t)M * D, OUT_SHG = OUT_SRW + 8388608, OUT_NK = OUT_SHG + 8388608, OUT_NV = OUT_NK + 16777216,
                 OUT_DK = OUT_NV + 16777216, OUT_DV = OUT_DK + 16777216, OUT_TOTAL = OUT_DV + 16777216;

constexpr int RING_BYTES = 131072;
constexpr int LDSCTL_OFF = RING_BYTES, MISC_OFF = LDSCTL_OFF + 320;
constexpr int LDS_BYTES = 147456;

#define GAS __attribute__((address_space(1)))
#define LAS __attribute__((address_space(3)))
#define DEVI __device__ __forceinline__
typedef unsigned short bf16;
typedef unsigned v4u __attribute__((ext_vector_type(4)));
typedef unsigned v2u __attribute__((ext_vector_type(2)));
typedef float f32x4 __attribute__((ext_vector_type(4)));
typedef float f32x2 __attribute__((ext_vector_type(2)));
typedef float f32x16 __attribute__((ext_vector_type(16)));
typedef short bf16x8 __attribute__((ext_vector_type(8)));
typedef short s16x4 __attribute__((ext_vector_type(4)));

typedef __bf16 bf16x2_t __attribute__((ext_vector_type(2)));
DEVI unsigned pk2(float lo, float hi) { f32x2 v = {lo, hi}; bf16x2_t b = __builtin_convertvector(v, bf16x2_t); return __builtin_bit_cast(unsigned, b); }
DEVI int launder_v(int x) { asm volatile("" : "+v"(x)); return x; }
DEVI int launder_i(int x) { asm volatile("" : "+s"(x)); return x; }
DEVI float sigmoidf_(float x) { return __builtin_amdgcn_rcpf(1.0f + __expf(-x)); }
DEVI float siluf_(float x) { return x * sigmoidf_(x); }
template <int CTRL> DEVI float dpp_f(float x) { return __builtin_bit_cast(float, __builtin_amdgcn_mov_dpp(__builtin_bit_cast(int, x), CTRL, 0xf, 0xf, true)); }
DEVI float sum8(float x) {
    x += dpp_f<0xB1>(x);
    x += dpp_f<0x4E>(x);
    x += dpp_f<0x141>(x);
    return x;
}
DEVI float sum16(float x) {
    x += dpp_f<0xB1>(x); x += dpp_f<0x4E>(x); x += dpp_f<0x141>(x); x += dpp_f<0x140>(x);
    return x;
}
DEVI float xrow16_sum(float x) {
    auto s = __builtin_amdgcn_permlane16_swap(__float_as_uint(x), __float_as_uint(x), false, false);
    x = __uint_as_float(s[0]) + __uint_as_float(s[1]);
    auto t = __builtin_amdgcn_permlane32_swap(__float_as_uint(x), __float_as_uint(x), false, false);
    return __uint_as_float(t[0]) + __uint_as_float(t[1]);
}
DEVI float wave_sum(float v) { return xrow16_sum(sum16(v)); }
DEVI float xhalf_max(float x) { auto rr = __builtin_amdgcn_permlane32_swap(__float_as_uint(x), __float_as_uint(x), false, false); return fmaxf(__uint_as_float(rr[0]), __uint_as_float(rr[1])); }
DEVI float xhalf_sum(float x) { auto rr = __builtin_amdgcn_permlane32_swap(__float_as_uint(x), __float_as_uint(x), false, false); return __uint_as_float(rr[0]) + __uint_as_float(rr[1]); }

#define XB_TMO      128
#define XB_XCNT(j)  (256  + 64 * (j))
#define XB_XSUB(j)  (1280 + 64 * (j))
#define XB_XGEN(j)  (2304 + 64 * (j))
#define XB_TOP      3328
#define XB_TOPGEN   3392
#define XCD_BAR_WORDS 3456
#define XB_SPIN_CAP (1u << 18)

__device__ __forceinline__ unsigned xb_ld(unsigned* p)              { return __hip_atomic_load(p, __ATOMIC_RELAXED, __HIP_MEMORY_SCOPE_AGENT); }
__device__ __forceinline__ unsigned xb_add(unsigned* p, unsigned v) { return __hip_atomic_fetch_add(p, v, __ATOMIC_RELAXED, __HIP_MEMORY_SCOPE_AGENT); }
__device__ __forceinline__ unsigned xb_xcc_id() { return (unsigned)__builtin_amdgcn_s_getreg((3 << 11) | 20) & 0xFu; }
#define XB_SPIN(cond, bar) do { unsigned _sp = 0; while (cond) { __builtin_amdgcn_s_sleep(1); \
    if ((++_sp & 255u) == 0u) { if (xb_ld(&(bar)[XB_TMO])) break; if (_sp > XB_SPIN_CAP) { atomicAdd(&(bar)[XB_TMO], 1u); break; } } } } while (0)

struct XcdBarrier { unsigned* bar; unsigned x; volatile LAS unsigned* st; };

__device__ __forceinline__ XcdBarrier xcd_barrier_post(unsigned* bar, volatile LAS unsigned* st) {
    XcdBarrier b; b.bar = bar; b.x = xb_xcc_id(); b.st = st;
    if (threadIdx.x == 0) (void)xb_add(&bar[XB_XCNT(b.x)], 1u);
    return b;
}
__device__ __forceinline__ void xcd_barrier_complete(unsigned* bar, unsigned x, unsigned& nloc, unsigned& nx) {
    const unsigned G = gridDim.x * gridDim.y * gridDim.z;
    unsigned sum, cnt, mine, sp = 0u;
    for (;;) {
        sum = 0u; cnt = 0u; mine = 0u;
#pragma unroll
        for (unsigned j = 0; j < 16; ++j) { const unsigned c = xb_ld(&bar[XB_XCNT(j)]); sum += c; cnt += (c > 0u) ? 1u : 0u; mine = (j == x) ? c : mine; }
        if (sum == G) break;
        __builtin_amdgcn_s_sleep(1);
        if ((++sp & 255u) == 0u) { if (xb_ld(&bar[XB_TMO])) break; if (sp > XB_SPIN_CAP) { atomicAdd(&bar[XB_TMO], 1u); break; } }
    }
    nloc = mine > 0u ? mine : 1u; nx = cnt > 0u ? cnt : 1u;
}
__device__ __forceinline__ void xcd_barrier(const XcdBarrier& b) {
    asm volatile("s_waitcnt vmcnt(0)" ::: "memory");
    __syncthreads();
    if (threadIdx.x == 0) {
        unsigned* bar = b.bar;
        __builtin_amdgcn_s_waitcnt(0);
        unsigned nloc = b.st[0], nx = b.st[1];
        if (nloc == 0u) { xcd_barrier_complete(bar, b.x, nloc, nx); b.st[0] = nloc; b.st[1] = nx; }
        const unsigned old = xb_add(&bar[XB_XSUB(b.x)], 1u);
        const unsigned gen = old / nloc;
        if (old + 1u == (gen + 1u) * nloc) {
            __builtin_amdgcn_fence(__ATOMIC_RELEASE, "agent");
            asm volatile("s_waitcnt vmcnt(0)" ::: "memory");
            const unsigned og = xb_add(&bar[XB_TOP], 1u);
            const unsigned tg = og / nx;
            if (og + 1u == (tg + 1u) * nx) xb_add(&bar[XB_TOPGEN], 1u);
            else XB_SPIN(xb_ld(&bar[XB_TOPGEN]) == tg, bar);
            __builtin_amdgcn_fence(__ATOMIC_ACQUIRE, "agent");
            xb_add(&bar[XB_XGEN(b.x)], 1u);
            asm volatile("s_waitcnt vmcnt(0)" ::: "memory");
        } else {
            XB_SPIN(xb_ld(&bar[XB_XGEN(b.x)]) == gen, bar);
            __builtin_amdgcn_fence(__ATOMIC_ACQUIRE, "agent");
            asm volatile("s_waitcnt vmcnt(0)" ::: "memory");
        }
    }
    __syncthreads();
}

#if defined(__HIP_DEVICE_COMPILE__)
#define KGAS GAS
#else
#define KGAS
#endif
struct Args { const KGAS float* in[35]; KGAS float* out; KGAS unsigned char* ws; };

DEVI void seq_pos(int m, int& t, int& T) { if (m < MP) { t = m & 255; T = 256; } else { t = (m - MP) & 2047; T = 2048; } }

DEVI void tr_item(const float* src, int lds_, int kvalid, bf16* dst, int ldd, LAS float* scr, int lane) {
    float v[32];
#pragma unroll
    for (int i = 0; i < 32; ++i) { const int kk = 2 * i + (lane >> 5); v[i] = (src != nullptr && kk < kvalid) ? src[(size_t)kk * lds_ + (lane & 31)] : 0.f; }
#pragma unroll
    for (int i = 0; i < 32; ++i) { const int kk = 2 * i + (lane >> 5); scr[kk * 33 + (lane & 31)] = v[i]; }
    asm volatile("s_waitcnt lgkmcnt(0)" ::: "memory");
    const int c = lane & 7;
#pragma unroll
    for (int j = 0; j < 4; ++j) { const int n = (lane >> 3) + 8 * j; const LAS float* s = scr + (8 * c) * 33 + n;
        v4u o; o.x = pk2(s[0 * 33], s[1 * 33]); o.y = pk2(s[2 * 33], s[3 * 33]); o.z = pk2(s[4 * 33], s[5 * 33]); o.w = pk2(s[6 * 33], s[7 * 33]);
        *(v4u*)(dst + (size_t)n * ldd + 8 * c) = o; }
    asm volatile("s_waitcnt lgkmcnt(0)" ::: "memory");
}
struct WSrc { const float *w1, *w2, *evin, *evout, *odin, *odout, *rw2, *ra2, *rg2; };
DEVI int layer_items(int L) { return (L & 1) ? (22016 + 11008 + 6144 + 2048) : (22016 + 11008 + 8704 + 2048 + 1920); }
DEVI void convert_layer_item(const WSrc& W, KGAS unsigned char* ws, int L, int it, LAS float* scr, int lane) {
    const int li = L >> 1;
    if (it < 22016) { const int sl = (it >= 11008) ? 1 : 0, r = it - sl * 11008, kb = r / 344, nb = r - kb * 344, n0 = nb * 32, k0 = kb * 64;
        const int pn = n0 >> 8, bj = (n0 >> 7) & 1, c = n0 & 127, ns = bj * FF + pn * 128 + c; const size_t mi = (size_t)(2 * L + sl);
        tr_item(W.w1 + mi * D * NF1 + (size_t)k0 * NF1 + ns, NF1, 64, (bf16*)(ws + WS_W1T) + mi * NF1 * D + (size_t)n0 * D + k0, D, scr, lane); return; }
    it -= 22016;
    if (it < 11008) { const int sl = (it >= 5504) ? 1 : 0, r = it - sl * 5504, kb = r >> 6, nb = r & 63, n0 = nb * 32, k0 = kb * 64; const size_t mi = (size_t)(2 * L + sl);
        tr_item(W.w2 + mi * FF * D + (size_t)k0 * D + n0, D, 64, (bf16*)(ws + WS_W2T) + mi * D * FF + (size_t)n0 * FF + k0, FF, scr, lane); return; }
    it -= 11008;
    const int nin = (L & 1) ? 6144 : 8704;
    if (it < nin) {
        if (L & 1) { const int kb = it / 192, nb = it - kb * 192, n0 = nb * 32, k0 = kb * 64;
            tr_item(W.odin + (size_t)li * D * ODC + (size_t)k0 * ODC + n0, ODC, 64, (bf16*)(ws + WS_ODIN) + (size_t)li * ODC * D + (size_t)n0 * D + k0, D, scr, lane); }
        else { const int kb = it / 272, nb = it - kb * 272, n0 = nb * 32, k0 = kb * 64;
            tr_item(n0 < EVC ? W.evin + (size_t)li * D * EVC + (size_t)k0 * EVC + n0 : nullptr, EVC, 64, (bf16*)(ws + WS_EVIN) + (size_t)li * EVP * D + (size_t)n0 * D + k0, D, scr, lane); }
        return; }
    it -= nin;
    if (it < 2048) { const int kb = it >> 6, nb = it & 63, n0 = nb * 32, k0 = kb * 64;
        tr_item(((L & 1) ? W.odout : W.evout) + (size_t)li * D * D + (size_t)k0 * D + n0, D, 64, (bf16*)(ws + ((L & 1) ? WS_ODOUT : WS_EVOUT)) + (size_t)li * D * D + (size_t)n0 * D + k0, D, scr, lane); return; }
    it -= 2048;
    { const int kb = it / 160, nb = it - kb * 160, n0 = nb * 32, seg = n0 >> 10, nloc = n0 & 1023;
      const float* w2 = W.rw2 + (size_t)li * 2 * 64 * 1024; const float* a2 = W.ra2 + (size_t)li * 2 * 64 * 1024; const float* g2 = W.rg2 + (size_t)li * 160 * 1024;
      const float* sp = nullptr; int kvalid = 64;
      if (seg == 0 && kb == 0) sp = w2 + nloc;
      else if (seg == 1 && kb == 2) sp = w2 + 64 * 1024 + nloc;
      else if (seg == 2 && kb == 4) sp = a2 + nloc;
      else if (seg == 3 && kb == 6) sp = a2 + 64 * 1024 + nloc;
      else if (seg == 4 && kb >= 8 && kb <= 10) { sp = g2 + (size_t)(kb - 8) * 64 * 1024 + nloc; kvalid = (kb == 10) ? 32 : 64; }
      tr_item(sp, 1024, kvalid, (bf16*)(ws + WS_LRW) + (size_t)li * 5120 * LK + (size_t)n0 * LK + kb * 64, LK, scr, lane); }
}
DEVI int list_items(int l) { return l < 0 ? 11008 : layer_items(l) - 11008 + (l < 3 ? 11008 : 0); }
DEVI int list_w1b_end(int l) { return 5504 + (layer_items(l) - 33024) + 11008; }
DEVI void convert_tail(const WSrc& W, KGAS unsigned char* ws, int l, unsigned* ctr, int maxgrabs, int stop_at, LAS unsigned char* lds, int tid, int wave, int lane) {
    volatile LAS unsigned* slot = (volatile LAS unsigned*)(lds + 98304 + 64);
    LAS float* scr = (LAS float*)(lds + wave * 8704);
    const int NI = list_items(l);
    for (int g = 0; g < maxgrabs; ++g) {
        if (tid == 0) { unsigned b_ = 0xffffffffu;
            if (stop_at >= (1 << 30) || __hip_atomic_load(ctr, __ATOMIC_RELAXED, __HIP_MEMORY_SCOPE_AGENT) < (unsigned)stop_at) b_ = __hip_atomic_fetch_add(ctr, 8u, __ATOMIC_RELAXED, __HIP_MEMORY_SCOPE_AGENT);
            *slot = b_; }
        __syncthreads();
        const unsigned base = *slot;
        __syncthreads();
        if (base >= (unsigned)NI) break;
        const int idx = (int)base + wave;
        if (idx < NI) { int L = l < 0 ? 0 : l, it = idx;
            if (l >= 0) { const int nmix = layer_items(l) - 33024;
                if (idx < 5504) it = 22016 + idx;
                else if (idx < 5504 + nmix) it = 33024 + (idx - 5504);
                else if (idx < 5504 + nmix + 11008) it = 11008 + (idx - 5504 - nmix);
                else if (idx < 5504 + nmix + 16512) it = 27520 + (idx - 5504 - nmix - 11008);
                else { L = l + 1; it = idx - (5504 + nmix + 16512); } }
            convert_layer_item(W, ws, L, it, scr, lane); }
    }
}

DEVI void ada_cond(const float* c_ctx, const float* c, LAS float* sc, int tid) {
    for (int i = tid; i < 3 * D; i += NTHR) { const int g = i / D, k = i - g * D; const float x = (g == 0) ? c_ctx[k] : c[(g - 1) * D + k]; sc[i] = siluf_(x); }
    __syncthreads();
}
DEVI void ada_item(const float* ada_w, const float* ada_b, float* MOD, int l, int n0, const LAS float* sc, LAS float* red, int tid) {
    const int c4 = tid % 18, ks = tid / 18;
    if (ks < 28) {
        const float* W = ada_w + (size_t)l * D * NMOD + n0 + 4 * c4;
        f32x4 a0 = {0.f, 0.f, 0.f, 0.f}, a1 = a0, a2 = a0;
#pragma unroll 8
        for (int k = ks; k < D; k += 28) { const f32x4 w = *(const f32x4*)(W + (size_t)k * NMOD); a0 += w * sc[k]; a1 += w * sc[D + k]; a2 += w * sc[2 * D + k]; }
        LAS float* r = red + ks * 216 + 4 * c4;
        *(LAS f32x4*)(r) = a0; *(LAS f32x4*)(r + 72) = a1; *(LAS f32x4*)(r + 144) = a2;
    }
    __syncthreads();
    if (tid < 216) { float s_ = 0.f;
#pragma unroll
        for (int j = 0; j < 28; ++j) s_ += red[j * 216 + tid];
        const int g = tid / 72, n = n0 + (tid - g * 72);
        MOD[((size_t)l * 3 + g) * NMOD + n] = s_ + ada_b[(size_t)l * NMOD + n]; }
    __syncthreads();
}

DEVI f32x4 bf4_to_f32(v2u a) { f32x4 r; r.x = __uint_as_float(a.x << 16); r.y = __uint_as_float(a.x & 0xffff0000u); r.z = __uint_as_float(a.y << 16); r.w = __uint_as_float(a.y & 0xffff0000u); return r; }
template <bool HAS_Y, bool HAS_H, bool XIN_B, bool XOUT_B>
DEVI void row_phase(const void* xa, const void* xb, const bf16* Y, void* xout, bf16* H, float fac,
                    const float* modv  , int gate_idx, const float* nw_post,
                    const float* modn  , int sh_idx, const float* nw_pre, LAS unsigned char* lds, int tid, int gw, int lane) {
    LAS float* pv = (LAS float*)lds;
#pragma unroll
    for (int g = 0; g < 3; ++g) { const int col = 4 * tid;
        if (HAS_Y) { const f32x4 gt = *(const f32x4*)(modv + (size_t)g * NMOD + gate_idx * D + col); const f32x4 nw = *(const f32x4*)(nw_post + col); *(LAS f32x4*)(pv + (g * 3 + 0) * D + col) = gt * nw * fac; }
        if (HAS_H) { const f32x4 sh = *(const f32x4*)(modn + (size_t)g * NMOD + sh_idx * D + col); const f32x4 scl = *(const f32x4*)(modn + (size_t)g * NMOD + (sh_idx + 1) * D + col); const f32x4 nw = *(const f32x4*)(nw_pre + col);
            *(LAS f32x4*)(pv + (g * 3 + 1) * D + col) = nw * (scl + 1.0f); *(LAS f32x4*)(pv + (g * 3 + 2) * D + col) = sh; } }
    __syncthreads();
    f32x4 nx[8]; v2u nxb[8], ny0[8], ny1[8];
#define RP_LOADX(m_) do { const size_t ro_ = ((m_) < MP) ? (size_t)(m_) * D : (size_t)((m_) - MP) * D; const void* base_ = ((m_) < MP) ? xa : xb; \
      _Pragma("unroll") for (int j = 0; j < 8; ++j) { if (XIN_B) nxb[j] = *(const v2u*)((const bf16*)base_ + ro_ + 4 * lane + 256 * j); else nx[j] = *(const f32x4*)((const float*)base_ + ro_ + 4 * lane + 256 * j); \
        if (HAS_Y) { ny0[j] = *(const v2u*)(Y + (size_t)(m_) * D + 4 * lane + 256 * j); ny1[j] = *(const v2u*)(Y + (size_t)(M + (m_)) * D + 4 * lane + 256 * j); } } } while (0)
    RP_LOADX(gw);
#pragma nounroll
    for (int i = 0; i < 6; ++i) {
        const int m = gw + 2048 * i;
        const int g = (i < 4) ? 0 : (i - 3);
        const LAS float* pg = pv + g * 3 * D + 4 * lane;
        f32x4 x[8], y[8];
#pragma unroll
        for (int j = 0; j < 8; ++j) { x[j] = XIN_B ? bf4_to_f32(nxb[j]) : nx[j]; if (HAS_Y) y[j] = bf4_to_f32(ny0[j]) + bf4_to_f32(ny1[j]); }
        if (i + 1 < 6) RP_LOADX(m + 2048);
        if (HAS_Y) {
            float ss = 0.f;
#pragma unroll
            for (int j = 0; j < 8; ++j) ss += (y[j].x * y[j].x + y[j].y * y[j].y) + (y[j].z * y[j].z + y[j].w * y[j].w);
            const float rs = rsqrtf(wave_sum(ss) * (1.0f / D) + NORM_EPS);
#pragma unroll
            for (int j = 0; j < 8; ++j) x[j] += *(const LAS f32x4*)(pg + 256 * j) * y[j] * rs;
        }
#pragma unroll
        for (int j = 0; j < 8; ++j) {
            if (XOUT_B) { v2u o; o.x = pk2(x[j].x, x[j].y); o.y = pk2(x[j].z, x[j].w); *(v2u*)((bf16*)xout + (size_t)m * D + 4 * lane + 256 * j) = o; }
            else *(f32x4*)((float*)xout + (size_t)m * D + 4 * lane + 256 * j) = x[j]; }
        if (HAS_H) {
            float ss = 0.f;
#pragma unroll
            for (int j = 0; j < 8; ++j) ss += (x[j].x * x[j].x + x[j].y * x[j].y) + (x[j].z * x[j].z + x[j].w * x[j].w);
            const float rs = rsqrtf(wave_sum(ss) * (1.0f / D) + NORM_EPS);
#pragma unroll
            for (int j = 0; j < 8; ++j) { const int col = 4 * lane + 256 * j;
                const f32x4 hv = x[j] * rs * *(const LAS f32x4*)(pg + D + 256 * j) + *(const LAS f32x4*)(pg + 2 * D + 256 * j); v2u o; o.x = pk2(hv.x, hv.y); o.y = pk2(hv.z, hv.w);
                *(v2u*)(H + (size_t)m * D + col) = o; }
        }
    }
#undef RP_LOADX
}

DEVI float bf1(bf16 v) { return __uint_as_float((unsigned)v << 16); }
DEVI float shifted(const bf16* U, int m, int col, float mu, int t, int T) {
    const float x = bf1(U[(size_t)m * EVP + col]);
    const float p = (t > 0) ? bf1(U[(size_t)(m - 1) * EVP + col]) : 0.f;
    const float n = (t < T - 1) ? bf1(U[(size_t)(m + 1) * EVP + col]) : 0.f;
    return x + mu * (0.5f * (p + n) - x);
}
DEVI f32x4 sigmoid4(f32x4 x) { f32x4 r; r.x = sigmoidf_(x.x); r.y = sigmoidf_(x.y); r.z = sigmoidf_(x.z); r.w = sigmoidf_(x.w); return r; }
DEVI void e1a_phase(const bf16* U, const float* mu, bf16* L, int gtid, int nthreads) {
    for (int idx = gtid; idx < M * (LK / 8); idx += nthreads) {
        const int m = idx / (LK / 8), k = (idx - m * (LK / 8)) * 8; int t, T; seq_pos(m, t, T);
        int col = -1, mode = 0;
        if (k < 512) { const int sec = k >> 7, o = k & 127; if (o < 64) { if (sec < 2) { col = 3232 + sec * 64 + o; } else { col = 3360 + (sec - 2) * 64 + o; mode = 1; } } }
        else if (k < 672) { col = 3072 + (k - 512); mode = 2; }
        v4u o4 = {0u, 0u, 0u, 0u};
        if (col >= 0) {
            const bf16* ub = U + (size_t)m * EVP + col;
            const v4u x4 = *(const v4u*)ub; v4u p4 = {0u, 0u, 0u, 0u}, n4 = p4;
            if (t > 0) p4 = *(const v4u*)(ub - EVP);
            if (t < T - 1) n4 = *(const v4u*)(ub + EVP);
            const f32x4 m0 = *(const f32x4*)(mu + col), m1 = *(const f32x4*)(mu + col + 4);
            f32x4 r0, r1;
            { const f32x4 x = bf4_to_f32((v2u){x4.x, x4.y}), p = bf4_to_f32((v2u){p4.x, p4.y}), n = bf4_to_f32((v2u){n4.x, n4.y}); r0 = x + m0 * ((p + n) * 0.5f - x); }
            { const f32x4 x = bf4_to_f32((v2u){x4.z, x4.w}), p = bf4_to_f32((v2u){p4.z, p4.w}), n = bf4_to_f32((v2u){n4.z, n4.w}); r1 = x + m1 * ((p + n) * 0.5f - x); }
            if (mode == 0) { r0.x = tanhf(r0.x); r0.y = tanhf(r0.y); r0.z = tanhf(r0.z); r0.w = tanhf(r0.w); r1.x = tanhf(r1.x); r1.y = tanhf(r1.y); r1.z = tanhf(r1.z); r1.w = tanhf(r1.w); }
            else if (mode == 2) { r0 = sigmoid4(r0); r1 = sigmoid4(r1); }
            o4.x = pk2(r0.x, r0.y); o4.y = pk2(r0.z, r0.w); o4.z = pk2(r1.x, r1.y); o4.w = pk2(r1.z, r1.w);
        }
        *(v4u*)(L + (size_t)m * LK + k) = o4;
    }
}
struct EvenPtrs {
    const bf16* U; const bf16* LR;
    float *RWV, *BONUS, *RWO, *HGO;
    const float *mu, *w0, *a0, *kk_w, *ka_w, *r_k, *ln_w, *ln_b, *lb0, *lb1, *hg_nw;
    int li;
};
DEVI f32x4 exp4(f32x4 x) { f32x4 r; r.x = __expf(x.x); r.y = __expf(x.y); r.z = __expf(x.z); r.w = __expf(x.w); return r; }
DEVI float hsum4(f32x4 x) { return (x.x + x.y) + (x.z + x.w); }
constexpr int SCH = 32;
DEVI void scan_rwkv_unit(const EvenPtrs& P, const float* st_in, float* st_out, int idx, LAS float* buf, int tid, int slab, int lane) {
    const bool sample = idx < 64; const int u = sample ? idx : idx - 64;
    const int h = u & 15, dir = (u >> 4) & 1, b = u >> 5, row0 = sample ? MP + b * 2048 : b * 256, T = sample ? 2048 : 256, nch = T / SCH;
    const size_t doff = (size_t)dir * M * 1024, soff = ((((size_t)b * 2 + P.li) * 2 + dir) * 16 + h) * 4096;
    float* Og = P.RWO + doff + h * 64; LAS float* obuf = buf + 2 * SCH * 384 + 64;
    const int r8 = lane >> 3, kg = lane & 7, vrow = slab * 8 + r8;
    f32x2 S[4];
    if (sample) {
#pragma unroll
        for (int j = 0; j < 4; ++j) S[j] = *(const f32x2*)(st_in + soff + vrow * 64 + kg * 8 + 2 * j);
    } else {
#pragma unroll
        for (int j = 0; j < 4; ++j) S[j] = (f32x2){0.f, 0.f};
    }
    const int lst = tid >> 4, lp = tid & 15, c = h * 64 + lp * 4;
    v2u ur[3], uk[3], uv[3]; f32x4 lw, la;
#define SC_LOAD(cn) do { const int s_ = (cn) * SCH + lst; const int t_ = dir ? (T - 1 - s_) : s_; const int m_ = row0 + t_; const bf16* ub_ = P.U + (size_t)m_ * EVP + c; \
        ur[1] = *(const v2u*)ub_; uk[1] = *(const v2u*)(ub_ + 1024); uv[1] = *(const v2u*)(ub_ + 2048); \
        const v2u z_ = {0u, 0u}; ur[0] = z_; uk[0] = z_; uv[0] = z_; ur[2] = z_; uk[2] = z_; uv[2] = z_; \
        if (t_ > 0) { ur[0] = *(const v2u*)(ub_ - EVP); uk[0] = *(const v2u*)(ub_ - EVP + 1024); uv[0] = *(const v2u*)(ub_ - EVP + 2048); } \
        if (t_ < T - 1) { ur[2] = *(const v2u*)(ub_ + EVP); uk[2] = *(const v2u*)(ub_ + EVP + 1024); uv[2] = *(const v2u*)(ub_ + EVP + 2048); } \
        const bf16* lr_ = P.LR + (size_t)m_ * 5120 + dir * 1024 + c; lw = bf4_to_f32(*(const v2u*)lr_); la = bf4_to_f32(*(const v2u*)(lr_ + 2048)); } while (0)
#define SC_STORE(bs, cn) do { const int s_ = (cn) * SCH + lst; const int t_ = dir ? (T - 1 - s_) : s_; const int m_ = row0 + t_; \
        const f32x4 mu_r = *(const f32x4*)(P.mu + c), mu_k = *(const f32x4*)(P.mu + 1024 + c), mu_v = *(const f32x4*)(P.mu + 2048 + c); \
        const f32x4 kkw = *(const f32x4*)(P.kk_w + c), kaw = *(const f32x4*)(P.ka_w + c), rk = *(const f32x4*)(P.r_k + c); \
        const f32x4 w0d = *(const f32x4*)(P.w0 + dir * 1024 + c), a0d = *(const f32x4*)(P.a0 + dir * 1024 + c); \
        const f32x4 r1_ = bf4_to_f32(ur[1]), k1_ = bf4_to_f32(uk[1]), v1_ = bf4_to_f32(uv[1]); \
        const f32x4 r_ = r1_ + mu_r * ((bf4_to_f32(ur[0]) + bf4_to_f32(ur[2])) * 0.5f - r1_), k_ = k1_ + mu_k * ((bf4_to_f32(uk[0]) + bf4_to_f32(uk[2])) * 0.5f - k1_), v_ = v1_ + mu_v * ((bf4_to_f32(uv[0]) + bf4_to_f32(uv[2])) * 0.5f - v1_); \
        const f32x4 kkv_ = k_ * kkw; const float nrm_ = sqrtf(sum16(hsum4(kkv_ * kkv_))); const f32x4 kk_ = kkv_ * (1.0f / fmaxf(nrm_, 1e-12f)); \
        const f32x4 dec_ = exp4(sigmoid4(w0d + lw) * (-0.6065306597126334f)); const f32x4 a_ = sigmoid4(a0d + la); const f32x4 kd_ = k_ * ((a_ - 1.0f) * kaw + 1.0f); \
        const float bon_ = sum16(hsum4(r_ * kd_ * rk)); if (lp == 0) P.BONUS[((size_t)dir * M + m_) * 16 + h] = bon_; \
        if (dir == 0) *(f32x4*)(P.RWV + (size_t)m_ * 1024 + c) = v_; \
        LAS float* d_ = buf + (bs) * (SCH * 384) + lst * 384 + lp * 4; \
        *(LAS f32x4*)(d_) = r_; *(LAS f32x4*)(d_ + 64) = kk_; *(LAS f32x4*)(d_ + 128) = v_; *(LAS f32x4*)(d_ + 192) = dec_; *(LAS f32x4*)(d_ + 256) = kd_; *(LAS f32x4*)(d_ + 320) = kk_ * a_; } while (0)
    SC_LOAD(0); SC_STORE(0, 0);
    __syncthreads();
    for (int c_ = 0; c_ < nch; ++c_) {
        if (c_ + 1 < nch) SC_LOAD(c_ + 1);
        const LAS float* cb = buf + (c_ & 1) * (SCH * 384);
        const LAS float* sp0 = cb + kg * 8;
        f32x4 nr0 = *(const LAS f32x4*)(sp0), nr1 = *(const LAS f32x4*)(sp0 + 4), nk0 = *(const LAS f32x4*)(sp0 + 64), nk1 = *(const LAS f32x4*)(sp0 + 68),
              nw0 = *(const LAS f32x4*)(sp0 + 192), nw1 = *(const LAS f32x4*)(sp0 + 196), nd0 = *(const LAS f32x4*)(sp0 + 256), nd1 = *(const LAS f32x4*)(sp0 + 260),
              nb0 = *(const LAS f32x4*)(sp0 + 320), nb1 = *(const LAS f32x4*)(sp0 + 324);
        float nvv = cb[128 + vrow];
        LAS float* ob = obuf + (c_ & 1) * (SCH * 64);
#pragma unroll 8
        for (int st = 0; st < SCH; ++st) {
            const f32x4 r0 = nr0, r1 = nr1, k0 = nk0, k1 = nk1, w0 = nw0, w1 = nw1, d0 = nd0, d1 = nd1, b0 = nb0, b1 = nb1; const float vv = nvv;
            { const LAS float* sp = cb + ((st + 1) & (SCH - 1)) * 384 + kg * 8;
              nr0 = *(const LAS f32x4*)(sp); nr1 = *(const LAS f32x4*)(sp + 4); nk0 = *(const LAS f32x4*)(sp + 64); nk1 = *(const LAS f32x4*)(sp + 68);
              nw0 = *(const LAS f32x4*)(sp + 192); nw1 = *(const LAS f32x4*)(sp + 196); nd0 = *(const LAS f32x4*)(sp + 256); nd1 = *(const LAS f32x4*)(sp + 260);
              nb0 = *(const LAS f32x4*)(sp + 320); nb1 = *(const LAS f32x4*)(sp + 324); nvv = cb[((st + 1) & (SCH - 1)) * 384 + 128 + vrow]; }
            const f32x2 kk2[4] = {{k0.x, k0.y}, {k0.z, k0.w}, {k1.x, k1.y}, {k1.z, k1.w}};
            const f32x2 w2[4] = {{w0.x, w0.y}, {w0.z, w0.w}, {w1.x, w1.y}, {w1.z, w1.w}};
            const f32x2 kd2[4] = {{d0.x, d0.y}, {d0.z, d0.w}, {d1.x, d1.y}, {d1.z, d1.w}};
            const f32x2 b2[4] = {{b0.x, b0.y}, {b0.z, b0.w}, {b1.x, b1.y}, {b1.z, b1.w}};
            const f32x2 r2[4] = {{r0.x, r0.y}, {r0.z, r0.w}, {r1.x, r1.y}, {r1.z, r1.w}};
            f32x2 sa2 = S[0] * kk2[0];
#pragma unroll
            for (int j = 1; j < 4; ++j) sa2 += S[j] * kk2[j];
            const float sa = -sum8(sa2.x + sa2.y);
            const f32x2 sav = {sa, sa}, vv2 = {vv, vv};
            f32x2 o2 = {0.f, 0.f};
#pragma unroll
            for (int j = 0; j < 4; ++j) { S[j] = S[j] * w2[j] + (sav * b2[j] + vv2 * kd2[j]); o2 += S[j] * r2[j]; }
            const float o = sum8(o2.x + o2.y);
            ob[st * 64 + vrow] = o;
        }
        if (c_ + 1 < nch) SC_STORE((c_ + 1) & 1, c_ + 1);
        __syncthreads();
        { const int s_ = c_ * SCH + lst; const int t_ = dir ? (T - 1 - s_) : s_;
          *(f32x4*)(Og + (size_t)(row0 + t_) * 1024 + lp * 4) = *(const LAS f32x4*)(ob + lst * 64 + lp * 4); }
    }
#undef SC_LOAD
#undef SC_STORE
    if (!sample) {
#pragma unroll
        for (int j = 0; j < 4; ++j) *(f32x2*)(st_out + soff + vrow * 64 + kg * 8 + 2 * j) = S[j];
    }
}
DEVI void scan_hgrn_unit(const EvenPtrs& P, const float* st_in, float* st_out, int idx, LAS float* buf, int tid, int slab, int lane) {
    const bool sample = idx < 64; const int u = sample ? idx : idx - 64;
    const int h = u & 15, dir = (u >> 4) & 1, b = u >> 5, row0 = sample ? MP + b * 2048 : b * 256, T = sample ? 2048 : 256, nch = T / SCH;
    const size_t doff = (size_t)dir * M * 1024, soff = ((((size_t)b * 2 + P.li) * 2 + dir) * 16 + h) * 4096;
    const int r8 = lane >> 3, kg = lane & 7, vcol = slab * 8 + r8;
    float* Og = P.HGO + doff + h * 64; LAS float* obuf = buf + 2 * SCH * 384 + 64;
    f32x2 S[4];
    if (sample) {
#pragma unroll
        for (int j = 0; j < 4; ++j) { S[j].x = st_in[soff + (kg * 8 + 2 * j) * 64 + vcol]; S[j].y = st_in[soff + (kg * 8 + 2 * j + 1) * 64 + vcol]; }
    } else {
#pragma unroll
        for (int j = 0; j < 4; ++j) S[j] = (f32x2){0.f, 0.f};
    }
    const int lst = tid >> 4, lp = tid & 15, c = h * 64 + lp * 4;
    f32x4 lb = {0.f, 0.f, 0.f, 0.f};
    if (P.li != 0) lb = sigmoid4(*(const f32x4*)(P.lb1 + dir * 1024 + c) - *(const f32x4*)(P.lb0 + dir * 1024 + c));
    f32x4 uq, uf, ui;
#define SH_LOAD(cn) do { const int s_ = (cn) * SCH + lst; const int t_ = dir ? (T - 1 - s_) : s_; const bf16* ub_ = P.U + (size_t)(row0 + t_) * EVP + ACOLS + c; \
        uq = bf4_to_f32(*(const v2u*)ub_); ui = bf4_to_f32(*(const v2u*)(ub_ + 1024)); uf = bf4_to_f32(*(const v2u*)(ub_ + 3072 + dir * 1024)); } while (0)
#define SH_STORE(bs) do { LAS float* d_ = buf + (bs) * (SCH * 192) + lst * 192 + lp * 4; \
        *(LAS f32x4*)(d_) = uq * sigmoid4(uq); *(LAS f32x4*)(d_ + 64) = lb + (1.0f - lb) * sigmoid4(uf); *(LAS f32x4*)(d_ + 128) = ui; } while (0)
    SH_LOAD(0); SH_STORE(0);
    __syncthreads();
    for (int c_ = 0; c_ < nch; ++c_) {
        if (c_ + 1 < nch) SH_LOAD(c_ + 1);
        const LAS float* cb = buf + (c_ & 1) * (SCH * 192);
        const LAS float* sp0 = cb + kg * 8;
        f32x4 nq0 = *(const LAS f32x4*)(sp0), nq1 = *(const LAS f32x4*)(sp0 + 4), nf0 = *(const LAS f32x4*)(sp0 + 64), nf1 = *(const LAS f32x4*)(sp0 + 68);
        float nvv = cb[128 + vcol];
        LAS float* ob = obuf + (c_ & 1) * (SCH * 64);
#pragma unroll 8
        for (int st = 0; st < SCH; ++st) {
            const f32x4 q0 = nq0, q1 = nq1, f0 = nf0, f1 = nf1; const float vv = nvv;
            { const LAS float* sp = cb + ((st + 1) & (SCH - 1)) * 192 + kg * 8;
              nq0 = *(const LAS f32x4*)(sp); nq1 = *(const LAS f32x4*)(sp + 4); nf0 = *(const LAS f32x4*)(sp + 64); nf1 = *(const LAS f32x4*)(sp + 68); nvv = cb[((st + 1) & (SCH - 1)) * 192 + 128 + vcol]; }
            const f32x2 q2[4] = {{q0.x, q0.y}, {q0.z, q0.w}, {q1.x, q1.y}, {q1.z, q1.w}};
            const f32x2 f2[4] = {{f0.x, f0.y}, {f0.z, f0.w}, {f1.x, f1.y}, {f1.z, f1.w}};
            const f32x2 vv2 = {vv, vv};
            f32x2 o2 = {0.f, 0.f};
#pragma unroll
            for (int j = 0; j < 4; ++j) { S[j] = vv2 + f2[j] * (S[j] - vv2); o2 += S[j] * q2[j]; }
            const float o = sum8(o2.x + o2.y);
            ob[st * 64 + vcol] = o;
        }
        if (c_ + 1 < nch) SH_STORE((c_ + 1) & 1);
        __syncthreads();
        { const int s_ = c_ * SCH + lst; const int t_ = dir ? (T - 1 - s_) : s_;
          *(f32x4*)(Og + (size_t)(row0 + t_) * 1024 + lp * 4) = *(const LAS f32x4*)(ob + lst * 64 + lp * 4); }
    }
#undef SH_LOAD
#undef SH_STORE
    if (!sample) {
#pragma unroll
        for (int j = 0; j < 4; ++j) { st_out[soff + (kg * 8 + 2 * j) * 64 + vcol] = S[j].x; st_out[soff + (kg * 8 + 2 * j + 1) * 64 + vcol] = S[j].y; }
    }
}
constexpr int WCH = 4;
DEVI void scan_rwkv_wave(const EvenPtrs& P, float* st_out, int u, LAS float* wbuf, int lane) {
    const int h = u & 15, dir = (u >> 4) & 1, b = u >> 5, row0 = b * 256; constexpr int T = 256, nch = T / WCH;
    const size_t doff = (size_t)dir * M * 1024, soff = ((((size_t)b * 2 + P.li) * 2 + dir) * 16 + h) * 4096;
    const int rg = lane >> 3, kg = lane & 7;
    float* O = P.RWO + doff + h * 64 + rg;
    f32x2 S[8][4];
#pragma unroll
    for (int j = 0; j < 8; ++j)
#pragma unroll
        for (int q = 0; q < 4; ++q) S[j][q] = (f32x2){0.f, 0.f};
    const int lst = lane >> 4, lp = lane & 15, c = h * 64 + lp * 4;
    v2u ur[3], uk[3], uv[3]; f32x4 lw, la;
    const int vp0 = ((4 * lp) & 7) * 8 + ((4 * lp) >> 3);
#define WL_LOAD(cn) do { const int s_ = (cn) * WCH + lst; const int t_ = dir ? (T - 1 - s_) : s_; const int m_ = row0 + t_; const bf16* ub_ = P.U + (size_t)m_ * EVP + c; \
        ur[1] = *(const v2u*)ub_; uk[1] = *(const v2u*)(ub_ + 1024); uv[1] = *(const v2u*)(ub_ + 2048); \
        const v2u z_ = {0u, 0u}; ur[0] = z_; uk[0] = z_; uv[0] = z_; ur[2] = z_; uk[2] = z_; uv[2] = z_; \
        if (t_ > 0) { ur[0] = *(const v2u*)(ub_ - EVP); uk[0] = *(const v2u*)(ub_ - EVP + 1024); uv[0] = *(const v2u*)(ub_ - EVP + 2048); } \
        if (t_ < T - 1) { ur[2] = *(const v2u*)(ub_ + EVP); uk[2] = *(const v2u*)(ub_ + EVP + 1024); uv[2] = *(const v2u*)(ub_ + EVP + 2048); } \
        const bf16* lr_ = P.LR + (size_t)m_ * 5120 + dir * 1024 + c; lw = bf4_to_f32(*(const v2u*)lr_); la = bf4_to_f32(*(const v2u*)(lr_ + 2048)); } while (0)
#define WL_STORE(bs, cn) do { const int s_ = (cn) * WCH + lst; const int t_ = dir ? (T - 1 - s_) : s_; const int m_ = row0 + t_; \
        const f32x4 mu_r = *(const f32x4*)(P.mu + c), mu_k = *(const f32x4*)(P.mu + 1024 + c), mu_v = *(const f32x4*)(P.mu + 2048 + c);     \
        const f32x4 kkw = *(const f32x4*)(P.kk_w + c), kaw = *(const f32x4*)(P.ka_w + c), rk = *(const f32x4*)(P.r_k + c); \
        const f32x4 w0d = *(const f32x4*)(P.w0 + dir * 1024 + c), a0d = *(const f32x4*)(P.a0 + dir * 1024 + c); \
        const f32x4 r1_ = bf4_to_f32(ur[1]), k1_ = bf4_to_f32(uk[1]), v1_ = bf4_to_f32(uv[1]); \
        const f32x4 r_ = r1_ + mu_r * ((bf4_to_f32(ur[0]) + bf4_to_f32(ur[2])) * 0.5f - r1_), k_ = k1_ + mu_k * ((bf4_to_f32(uk[0]) + bf4_to_f32(uk[2])) * 0.5f - k1_), v_ = v1_ + mu_v * ((bf4_to_f32(uv[0]) + bf4_to_f32(uv[2])) * 0.5f - v1_); \
        const f32x4 kkv_ = k_ * kkw; const float nrm_ = sqrtf(sum16(hsum4(kkv_ * kkv_))); const f32x4 kk_ = kkv_ * (1.0f / fmaxf(nrm_, 1e-12f)); \
        const f32x4 dec_ = exp4(sigmoid4(w0d + lw) * (-0.6065306597126334f)); const f32x4 a_ = sigmoid4(a0d + la); const f32x4 kd_ = k_ * ((a_ - 1.0f) * kaw + 1.0f); \
        const float bon_ = sum16(hsum4(r_ * kd_ * rk)); if (lp == 0) P.BONUS[((size_t)dir * M + m_) * 16 + h] = bon_; \
        if (dir == 0) *(f32x4*)(P.RWV + (size_t)m_ * 1024 + c) = v_; \
        LAS float* d_ = wbuf + (bs) * (WCH * 384) + lst * 384; \
        *(LAS f32x4*)(d_ + lp * 4) = r_; *(LAS f32x4*)(d_ + 64 + lp * 4) = kk_; *(LAS f32x4*)(d_ + 192 + lp * 4) = dec_; *(LAS f32x4*)(d_ + 256 + lp * 4) = kd_; *(LAS f32x4*)(d_ + 320 + lp * 4) = kk_ * a_; \
        d_[128 + vp0] = v_.x; d_[128 + vp0 + 8] = v_.y; d_[128 + vp0 + 16] = v_.z; d_[128 + vp0 + 24] = v_.w; } while (0)
    WL_LOAD(0); WL_STORE(0, 0);
#pragma nounroll
    for (int c_ = 0; c_ < nch; ++c_) {
        if (c_ + 1 < nch) WL_LOAD(c_ + 1);
        const LAS float* cb = wbuf + (c_ & 1) * (WCH * 384);
#pragma unroll
        for (int st = 0; st < WCH; ++st) {
            const LAS float* sp = cb + st * 384 + kg * 8;
            const f32x4 r0 = *(const LAS f32x4*)(sp), r1 = *(const LAS f32x4*)(sp + 4), k0 = *(const LAS f32x4*)(sp + 64), k1 = *(const LAS f32x4*)(sp + 68);
            const f32x4 w0 = *(const LAS f32x4*)(sp + 192), w1 = *(const LAS f32x4*)(sp + 196), d0 = *(const LAS f32x4*)(sp + 256), d1 = *(const LAS f32x4*)(sp + 260);
            const f32x4 b0 = *(const LAS f32x4*)(sp + 320), b1 = *(const LAS f32x4*)(sp + 324);
            const f32x4 va = *(const LAS f32x4*)(cb + st * 384 + 128 + rg * 8), vb = *(const LAS f32x4*)(cb + st * 384 + 132 + rg * 8);
            const float vvs[8] = {va.x, va.y, va.z, va.w, vb.x, vb.y, vb.z, vb.w};
            const f32x2 kk2[4] = {{k0.x, k0.y}, {k0.z, k0.w}, {k1.x, k1.y}, {k1.z, k1.w}};
            const f32x2 w2[4] = {{w0.x, w0.y}, {w0.z, w0.w}, {w1.x, w1.y}, {w1.z, w1.w}};
            const f32x2 kd2[4] = {{d0.x, d0.y}, {d0.z, d0.w}, {d1.x, d1.y}, {d1.z, d1.w}};
            const f32x2 b2[4] = {{b0.x, b0.y}, {b0.z, b0.w}, {b1.x, b1.y}, {b1.z, b1.w}};
            const f32x2 r2[4] = {{r0.x, r0.y}, {r0.z, r0.w}, {r1.x, r1.y}, {r1.z, r1.w}};
            const int s_ = c_ * WCH + st; const int t_ = dir ? (T - 1 - s_) : s_;
            float* Ot = O + (size_t)(row0 + t_) * 1024;
#pragma unroll
            for (int j = 0; j < 8; ++j) {
                f32x2 sa2 = S[j][0] * kk2[0];
#pragma unroll
                for (int q = 1; q < 4; ++q) sa2 += S[j][q] * kk2[q];
                const float sa = -sum8(sa2.x + sa2.y);
                const f32x2 sav = {sa, sa}, vv2 = {vvs[j], vvs[j]};
                f32x2 o2 = {0.f, 0.f};
#pragma unroll
                for (int q = 0; q < 4; ++q) { S[j][q] = S[j][q] * w2[q] + (sav * b2[q] + vv2 * kd2[q]); o2 += S[j][q] * r2[q]; }
                Ot[8 * j] = sum8(o2.x + o2.y);
            }
        }
        if (c_ + 1 < nch) WL_STORE((c_ + 1) & 1, c_ + 1);
    }
#undef WL_LOAD
#undef WL_STORE
#pragma unroll
    for (int j = 0; j < 8; ++j) { float* so = st_out + soff + (rg + 8 * j) * 64 + kg * 8;
        *(f32x4*)so = (f32x4){S[j][0].x, S[j][0].y, S[j][1].x, S[j][1].y}; *(f32x4*)(so + 4) = (f32x4){S[j][2].x, S[j][2].y, S[j][3].x, S[j][3].y}; }
}
DEVI void scan_hgrn_wave(const EvenPtrs& P, float* st_out, int u, LAS float* wbuf, int lane) {
    const int h = u & 15, dir = (u >> 4) & 1, b = u >> 5, row0 = b * 256; constexpr int T = 256, nch = T / WCH;
    const size_t doff = (size_t)dir * M * 1024, soff = ((((size_t)b * 2 + P.li) * 2 + dir) * 16 + h) * 4096;
    const int cg = lane >> 3, kg = lane & 7;
    float* O = P.HGO + doff + h * 64 + cg;
    f32x2 S[8][4];
#pragma unroll
    for (int j = 0; j < 8; ++j)
#pragma unroll
        for (int q = 0; q < 4; ++q) S[j][q] = (f32x2){0.f, 0.f};
    const int lst = lane >> 4, lp = lane & 15, c = h * 64 + lp * 4;
    const int vp0 = ((4 * lp) & 7) * 8 + ((4 * lp) >> 3);
    f32x4 lb = {0.f, 0.f, 0.f, 0.f};
    if (P.li != 0) lb = sigmoid4(*(const f32x4*)(P.lb1 + dir * 1024 + c) - *(const f32x4*)(P.lb0 + dir * 1024 + c));
    v2u uq, uf, ui;
#define WH_LOAD(cn) do { const int s_ = (cn) * WCH + lst; const int t_ = dir ? (T - 1 - s_) : s_; const bf16* ub_ = P.U + (size_t)(row0 + t_) * EVP + ACOLS + c; \
        uq = *(const v2u*)ub_; ui = *(const v2u*)(ub_ + 1024); uf = *(const v2u*)(ub_ + 3072 + dir * 1024); } while (0)
#define WH_STORE(bs) do { LAS float* d_ = wbuf + (bs) * (WCH * 192) + lst * 192; const f32x4 q_ = bf4_to_f32(uq), i_ = bf4_to_f32(ui); \
        *(LAS f32x4*)(d_ + lp * 4) = q_ * sigmoid4(q_); *(LAS f32x4*)(d_ + 64 + lp * 4) = lb + (1.0f - lb) * sigmoid4(bf4_to_f32(uf)); \
        d_[128 + vp0] = i_.x; d_[128 + vp0 + 8] = i_.y; d_[128 + vp0 + 16] = i_.z; d_[128 + vp0 + 24] = i_.w; } while (0)
    WH_LOAD(0); WH_STORE(0);
#pragma nounroll
    for (int c_ = 0; c_ < nch; ++c_) {
        if (c_ + 1 < nch) WH_LOAD(c_ + 1);
        const LAS float* cb = wbuf + (c_ & 1) * (WCH * 192);
#pragma unroll
        for (int st = 0; st < WCH; ++st) {
            const LAS float* sp = cb + st * 192 + kg * 8;
            const f32x4 q0 = *(const LAS f32x4*)(sp), q1 = *(const LAS f32x4*)(sp + 4), f0 = *(const LAS f32x4*)(sp + 64), f1 = *(const LAS f32x4*)(sp + 68);
            const f32x4 va = *(const LAS f32x4*)(cb + st * 192 + 128 + cg * 8), vb = *(const LAS f32x4*)(cb + st * 192 + 132 + cg * 8);
            const float vvs[8] = {va.x, va.y, va.z, va.w, vb.x, vb.y, vb.z, vb.w};
            const f32x2 q2[4] = {{q0.x, q0.y}, {q0.z, q0.w}, {q1.x, q1.y}, {q1.z, q1.w}};
            const f32x2 f2[4] = {{f0.x, f0.y}, {f0.z, f0.w}, {f1.x, f1.y}, {f1.z, f1.w}};
            const int s_ = c_ * WCH + st; const int t_ = dir ? (T - 1 - s_) : s_;
            float* Ot = O + (size_t)(row0 + t_) * 1024;
#pragma unroll
            for (int j = 0; j < 8; ++j) {
                const f32x2 vv2 = {vvs[j], vvs[j]};
                f32x2 o2 = {0.f, 0.f};
#pragma unroll
                for (int q = 0; q < 4; ++q) { S[j][q] = vv2 + f2[q] * (S[j][q] - vv2); o2 += S[j][q] * q2[q]; }
                Ot[8 * j] = sum8(o2.x + o2.y);
            }
        }
        if (c_ + 1 < nch) WH_STORE((c_ + 1) & 1);
    }
#undef WH_LOAD
#undef WH_STORE
#pragma unroll
    for (int j = 0; j < 8; ++j)
#pragma unroll
        for (int q = 0; q < 4; ++q) { float* so = st_out + soff + (size_t)(kg * 8 + 2 * q) * 64 + cg + 8 * j; so[0] = S[j][q].x; so[64] = S[j][q].y; }
}
DEVI void e2_phase(const EvenPtrs& P, const float* st_rwkv, const float* st_hgrn, float* out_rwkv, float* out_hgrn, unsigned* qctr, LAS unsigned char* lds, int tid, int wave, int lane) {
    LAS float* buf = (LAS float*)lds;
    volatile LAS unsigned* slot = (volatile LAS unsigned*)(lds + 2 * SCH * 384 * 4);
    for (;;) {
        if (tid == 0) *slot = __hip_atomic_fetch_add(qctr, 1u, __ATOMIC_RELAXED, __HIP_MEMORY_SCOPE_AGENT);
        __syncthreads();
        const int task = (int)*slot;
        __syncthreads();
        if (task >= 384 + (P.li == 0 ? 512 : 256)) break;
        if (task >= 384) {
            const float* const* pt_ = (const float* const*)((KGAS unsigned char*)P.RWO - (WS_RWO - WS_PTRS));
            const float* c_ctx = pt_[0]; const float* c_lat = pt_[1]; const float* ada_w = pt_[2]; const float* ada_b = pt_[3];
            const int t2_ = launder_v(tid);
            ada_cond(c_ctx, c_lat, buf, t2_);
            ada_item(ada_w, ada_b, (float*)((KGAS unsigned char*)P.RWO - (WS_RWO - WS_MOD)), 2 * P.li + 1 + ((task - 384) >> 8), ((task - 384) & 255) * 72, buf, buf + 6144, t2_);
            continue; }
        if (task < 64) scan_rwkv_unit(P, st_rwkv, out_rwkv, task, buf, tid, wave, lane);
        else if (task < 128) scan_hgrn_unit(P, st_hgrn, out_hgrn, task - 64, buf, tid, wave, lane);
        else if (task < 256) scan_rwkv_wave(P, out_rwkv, (task - 128) * 8 + wave, buf + wave * (2 * WCH * 384), lane);
        else scan_hgrn_wave(P, out_hgrn, (task - 256) * 8 + wave, buf + wave * (2 * WCH * 384), lane);
    }
}
DEVI void e3_phase(const EvenPtrs& P, bf16* MIXO, int gw, int NGW, int lane) {
    const int hq = gw & 3, c = hq * 256 + 4 * lane;
    const f32x4 lnw = *(const f32x4*)(P.ln_w + c), lnb = *(const f32x4*)(P.ln_b + c), hnw = *(const f32x4*)(P.hg_nw + c);
    for (int it = gw; it < M * 4; it += NGW) {
        const int m = it >> 2;
        const size_t o1 = (size_t)m * 1024 + c;
        f32x4 o = *(const f32x4*)(P.RWO + o1) + *(const f32x4*)(P.RWO + (size_t)M * 1024 + o1);
        f32x4 ob = *(const f32x4*)(P.HGO + o1) + *(const f32x4*)(P.HGO + (size_t)M * 1024 + o1);
        const f32x4 vv = *(const f32x4*)(P.RWV + o1), gg = bf4_to_f32(*(const v2u*)(P.LR + (size_t)m * 5120 + 4096 + c)), ug = bf4_to_f32(*(const v2u*)(P.U + (size_t)m * EVP + ACOLS + 2048 + c));
        const float bonus = P.BONUS[(size_t)m * 16 + hq * 4 + (lane >> 4)] + P.BONUS[((size_t)M + m) * 16 + hq * 4 + (lane >> 4)];
        const float mean = sum16(hsum4(o)) * (1.0f / 64.0f);
        const f32x4 dlt = o - mean;
        const float var = sum16(hsum4(dlt * dlt)) * (1.0f / 64.0f);
        o = dlt * rsqrtf(var + 64e-5f) * lnw + lnb;
        o = (o + vv * bonus) * gg;
        const float ms = sum16(hsum4(ob * ob)) * (1.0f / 64.0f);
        ob = ob * rsqrtf(ms + NORM_EPS) * hnw * (ug * sigmoid4(ug));
        v2u w0, w1; w0.x = pk2(o.x, o.y); w0.y = pk2(o.z, o.w); w1.x = pk2(ob.x, ob.y); w1.y = pk2(ob.z, ob.w);
        *(v2u*)(MIXO + (size_t)m * D + c) = w0; *(v2u*)(MIXO + (size_t)m * D + 1024 + c) = w1;
    }
}

constexpr float QSCALE = 0.125f * LOG2E;
struct OddPtrs {
    const bf16* UB; const bf16 *CNK, *CNV, *CDK, *CDV;
    const float *rpb, *dlam, *dnw;
    int li; float lam_init;
};
DEVI int crow(int reg, int h) { return (reg & 3) + 8 * (reg >> 2) + 4 * h; }
#define MFMA32(a, b, c) __builtin_amdgcn_mfma_f32_32x32x16_bf16((a), (b), (c), 0, 0, 0)
typedef short v4i16_t __attribute__((ext_vector_type(4)));
DEVI s16x4 vtr(const LAS unsigned char* p) { return __builtin_bit_cast(s16x4, __builtin_amdgcn_ds_read_tr16_b64_v4i16((LAS v4i16_t*)p)); }
constexpr int AKP = 272, ATB = 32 * AKP;
struct NaMask { int on; int qc; int c0; int dr; int kc0; const LAS float* rpb; };
template <int DVT>
DEVI void attn_tile(f32x16 (&O)[DVT], float& m_run, float& l_run, const bf16x8 (&qf)[4], const LAS unsigned char* Kt, const LAS unsigned char* Vt, const NaMask nm, int lane) {
    const int r = lane & 31, h = lane >> 5, i16 = lane & 15, q = i16 >> 2, p = i16 & 3, blk = (lane >> 4) & 1;
    bf16x8 kf[4];
#pragma unroll
    for (int ks = 0; ks < 4; ++ks) kf[ks] = *(const LAS bf16x8*)(Kt + r * AKP + 32 * ks + 16 * h);
    f32x16 S;
#pragma unroll
    for (int i = 0; i < 16; ++i) S[i] = 0.f;
#pragma unroll
    for (int ks = 0; ks < 4; ++ks) S = MFMA32(kf[ks], qf[ks], S);
    if (nm.on) {
#pragma unroll
        for (int i = 0; i < 16; ++i) { const int kc = nm.kc0 + crow(i, h); const bool ok = (kc >= nm.c0) && (kc < nm.c0 + 16);
            int dc = kc - nm.qc + 15; dc = dc < 0 ? 0 : (dc > 30 ? 30 : dc);
            const float bias = nm.rpb[nm.dr * 31 + dc] * LOG2E;
            S[i] = ok ? S[i] + bias : -1e30f; }
    }
    float mx = S[0];
#pragma unroll
    for (int i = 1; i < 16; ++i) mx = fmaxf(mx, S[i]);
    mx = xhalf_max(mx);
    const float m_old = m_run, m_new = fmaxf(m_run, mx), alpha = __builtin_amdgcn_exp2f(m_run - m_new);
    float rs = 0.f;
#pragma unroll
    for (int i = 0; i < 16; ++i) { S[i] = __builtin_amdgcn_exp2f(S[i] - m_new); rs += S[i]; }
    rs = xhalf_sum(rs);
    l_run = l_run * alpha + rs; m_run = m_new;
    if (!__all(m_new == m_old)) {
#pragma unroll
        for (int dt = 0; dt < DVT; ++dt)
#pragma unroll
            for (int i = 0; i < 16; ++i) O[dt][i] *= alpha;
    }
    bf16x8 pf[2];
#pragma unroll
    for (int s = 0; s < 2; ++s) { v4u pk; pk.x = pk2(S[8 * s + 0], S[8 * s + 1]); pk.y = pk2(S[8 * s + 2], S[8 * s + 3]); pk.z = pk2(S[8 * s + 4], S[8 * s + 5]); pk.w = pk2(S[8 * s + 6], S[8 * s + 7]);
        pf[s] = __builtin_bit_cast(bf16x8, pk); }
    const LAS unsigned char* vb = Vt + (4 * h + q) * AKP + (16 * blk + 4 * p) * 2;
#pragma unroll
    for (int dt = 0; dt < DVT; ++dt)
#pragma unroll
        for (int s = 0; s < 2; ++s) { const s16x4 lo = vtr(vb + (16 * s) * AKP + 64 * dt), hi = vtr(vb + (16 * s + 8) * AKP + 64 * dt);
            const bf16x8 vf = __builtin_shufflevector(lo, hi, 0, 1, 2, 3, 4, 5, 6, 7);
            O[dt] = MFMA32(vf, pf[s], O[dt]); }
}
template <int NE, int DVT>
DEVI void attn_unit(f32x16 (&O)[DVT], float& m_run, float& l_run, const bf16x8 (&qf)[4], const bf16* K0, const bf16* V0, int ld0, int n0, const bf16* K1, const bf16* V1, int ld1, int n1,
                    int koffb, int na, int na_kmin, int na_gr, int na_qc, const LAS float* rpb_h, LAS unsigned char* lds, int tid, int lane) {
    const bool isV = (NE == 1) ? (tid >= 256) : false;
    const int row = (NE == 1) ? ((tid & 255) >> 3) : (tid >> 4), pc = (NE == 1) ? (tid & 7) : (tid & 15);
    v4u sa[NE], sb[NE], sc[NE];
#define AT_LOAD(st, kt_) do { const bool sg_ = (kt_) >= n0; const int kk_ = sg_ ? (kt_) - n0 : (kt_); const int ld_ = sg_ ? ld1 : ld0; const size_t ro_ = (size_t)(kk_ * 32 + row) * ld_ + pc * 8; \
        const bf16* kp_ = (sg_ ? K1 : K0) + ro_; const bf16* vp_ = (sg_ ? V1 : V0) + ro_; \
        if (NE == 1) st[0] = *(const v4u*)(isV ? vp_ : kp_); else { st[0] = *(const v4u*)kp_; st[NE - 1] = *(const v4u*)vp_; } } while (0)
#define AT_STORE(st, b_) do { LAS unsigned char* kb_ = lds + (b_) * 2 * ATB + row * AKP + pc * 16; \
        if (NE == 1) *(LAS v4u*)(kb_ + (isV ? ATB : 0)) = st[0]; else { *(LAS v4u*)kb_ = st[0]; *(LAS v4u*)(kb_ + ATB) = st[NE - 1]; } } while (0)
    const int nt = n0 + n1;
    int kr0 = na_gr - 4; kr0 = kr0 < 0 ? 0 : (kr0 > 24 ? 24 : kr0);
    int c0 = na_qc - 8; c0 = c0 < 0 ? 0 : (c0 > 48 ? 48 : c0);
    AT_LOAD(sa, 0); AT_STORE(sa, 0);
    AT_LOAD(sa, 1);
    AT_LOAD(sb, 2);
    __syncthreads();
#define AT_ITER(kt, st_store, st_load) do { \
        { const int lt_ = ((kt) + 3 < nt) ? (kt) + 3 : nt - 1; AT_LOAD(st_load, lt_); }     \
        NaMask nm{0, 0, 0, 0, 0, nullptr}; bool active = true; \
        if (na && (kt) >= n0) { const int j = (kt) - n0, krow = na_kmin + (j >> 1); active = (krow >= kr0) && (krow < kr0 + 8); nm = NaMask{1, na_qc, c0, krow - na_gr + 7, 32 * (j & 1), rpb_h}; } \
        if (active) attn_tile<DVT>(O, m_run, l_run, qf, lds + ((kt) & 1) * 2 * ATB + koffb, lds + ((kt) & 1) * 2 * ATB + ATB, nm, lane); \
        if ((kt) + 1 < nt) AT_STORE(st_store, ((kt) + 1) & 1); \
        asm volatile("s_waitcnt lgkmcnt(0)" ::: "memory"); __builtin_amdgcn_s_barrier(); asm volatile("" ::: "memory"); } while (0)
#pragma nounroll
    for (int kt = 0; kt < nt; kt += 3) {
        AT_ITER(kt, sa, sc);
        if (kt + 1 < nt) AT_ITER(kt + 1, sb, sa);
        if (kt + 2 < nt) AT_ITER(kt + 2, sc, sb);
    }
#undef AT_ITER
#undef AT_LOAD
#undef AT_STORE
}
template <int DVT>
DEVI void attn_tile64(f32x16 (&O)[DVT], float& m_run, float& l_run, const bf16x8 (&qf)[4], const LAS unsigned char* Kt, const LAS unsigned char* Vt, int lane) {
    const int r = lane & 31, h = lane >> 5, i16 = lane & 15, q = i16 >> 2, p = i16 & 3, blk = (lane >> 4) & 1;
    bf16x8 ka[4], kb[4];
#pragma unroll
    for (int ks = 0; ks < 4; ++ks) { ka[ks] = *(const LAS bf16x8*)(Kt + r * AKP + 32 * ks + 16 * h); kb[ks] = *(const LAS bf16x8*)(Kt + (32 + r) * AKP + 32 * ks + 16 * h); }
    f32x16 S0, S1;
#pragma unroll
    for (int i = 0; i < 16; ++i) { S0[i] = 0.f; S1[i] = 0.f; }
#pragma unroll
    for (int ks = 0; ks < 4; ++ks) { S0 = MFMA32(ka[ks], qf[ks], S0); S1 = MFMA32(kb[ks], qf[ks], S1); }
    float mxa = fmaxf(fmaxf(fmaxf(S0[0], S0[1]), fmaxf(S0[2], S0[3])), fmaxf(fmaxf(S0[4], S0[5]), fmaxf(S0[6], S0[7])));
    float mxb = fmaxf(fmaxf(fmaxf(S0[8], S0[9]), fmaxf(S0[10], S0[11])), fmaxf(fmaxf(S0[12], S0[13]), fmaxf(S0[14], S0[15])));
    float mxc = fmaxf(fmaxf(fmaxf(S1[0], S1[1]), fmaxf(S1[2], S1[3])), fmaxf(fmaxf(S1[4], S1[5]), fmaxf(S1[6], S1[7])));
    float mxd = fmaxf(fmaxf(fmaxf(S1[8], S1[9]), fmaxf(S1[10], S1[11])), fmaxf(fmaxf(S1[12], S1[13]), fmaxf(S1[14], S1[15])));
    const float mx = xhalf_max(fmaxf(fmaxf(mxa, mxb), fmaxf(mxc, mxd)));
    const float m_old = m_run, m_new = fmaxf(m_run, mx), alpha = __builtin_amdgcn_exp2f(m_run - m_new);
#pragma unroll
    for (int i = 0; i < 16; ++i) { S0[i] = __builtin_amdgcn_exp2f(S0[i] - m_new); S1[i] = __builtin_amdgcn_exp2f(S1[i] - m_new); }
    const float ra = ((S0[0] + S0[1]) + (S0[2] + S0[3])) + ((S0[4] + S0[5]) + (S0[6] + S0[7])), rb = ((S0[8] + S0[9]) + (S0[10] + S0[11])) + ((S0[12] + S0[13]) + (S0[14] + S0[15]));
    const float rc = ((S1[0] + S1[1]) + (S1[2] + S1[3])) + ((S1[4] + S1[5]) + (S1[6] + S1[7])), rd = ((S1[8] + S1[9]) + (S1[10] + S1[11])) + ((S1[12] + S1[13]) + (S1[14] + S1[15]));
    const float rs = xhalf_sum((ra + rb) + (rc + rd));
    l_run = l_run * alpha + rs; m_run = m_new;
    if (!__all(m_new == m_old)) {
#pragma unroll
        for (int dt = 0; dt < DVT; ++dt)
#pragma unroll
            for (int i = 0; i < 16; ++i) O[dt][i] *= alpha;
    }
    bf16x8 pf[4];
#pragma unroll
    for (int s = 0; s < 2; ++s) { v4u pa, pb;
        pa.x = pk2(S0[8 * s + 0], S0[8 * s + 1]); pa.y = pk2(S0[8 * s + 2], S0[8 * s + 3]); pa.z = pk2(S0[8 * s + 4], S0[8 * s + 5]); pa.w = pk2(S0[8 * s + 6], S0[8 * s + 7]);
        pb.x = pk2(S1[8 * s + 0], S1[8 * s + 1]); pb.y = pk2(S1[8 * s + 2], S1[8 * s + 3]); pb.z = pk2(S1[8 * s + 4], S1[8 * s + 5]); pb.w = pk2(S1[8 * s + 6], S1[8 * s + 7]);
        pf[s] = __builtin_bit_cast(bf16x8, pa); pf[2 + s] = __builtin_bit_cast(bf16x8, pb); }
    const LAS unsigned char* vb = Vt + (4 * h + q) * AKP + (16 * blk + 4 * p) * 2;
#pragma unroll
    for (int s4 = 0; s4 < 4; ++s4)
#pragma unroll
        for (int dt = 0; dt < DVT; ++dt) { const s16x4 lo = vtr(vb + (16 * s4) * AKP + 64 * dt), hi = vtr(vb + (16 * s4 + 8) * AKP + 64 * dt);
            const bf16x8 vf = __builtin_shufflevector(lo, hi, 0, 1, 2, 3, 4, 5, 6, 7);
            O[dt] = MFMA32(vf, pf[s4], O[dt]); }
}
constexpr int ATB64 = 64 * AKP;
template <int NE, int DVT>
DEVI void attn_unit64(f32x16 (&O)[DVT], float& m_run, float& l_run, const bf16x8 (&qf)[4], const bf16* K0, const bf16* V0, int ld0, int n0, const bf16* K1, const bf16* V1, int ld1, int n1,
                      int koffb, LAS unsigned char* lds, int tid, int lane) {
    const int row = (NE == 1) ? (tid >> 3) : (tid >> 4), pc = (NE == 1) ? (tid & 7) : (tid & 15);
    const int nt = n0 + n1;
    v4u ka_[NE], va_[NE], kb_[NE], vb_[NE];
#define A6_LOAD(kS, vS, kt_) do { const int kc_ = (kt_) < nt ? (kt_) : nt - 1; const bool sg_ = kc_ >= n0; const int kk_ = sg_ ? kc_ - n0 : kc_; const int ld_ = sg_ ? ld1 : ld0; \
        const bf16* kp_ = (sg_ ? K1 : K0) + (size_t)(kk_ * 64 + row) * ld_ + pc * 8; const bf16* vp_ = (sg_ ? V1 : V0) + (size_t)(kk_ * 64 + row) * ld_ + pc * 8; \
        _Pragma("unroll") for (int e_ = 0; e_ < NE; ++e_) { kS[e_] = *(const v4u*)(kp_ + (size_t)(32 * e_) * ld_); vS[e_] = *(const v4u*)(vp_ + (size_t)(32 * e_) * ld_); } } while (0)
#define A6_STORE(kS, vS, b_) do { LAS unsigned char* d_ = lds + (b_) * ATB64 + row * AKP + pc * 16; \
        _Pragma("unroll") for (int e_ = 0; e_ < NE; ++e_) { *(LAS v4u*)(d_ + (32 * e_) * AKP) = kS[e_]; *(LAS v4u*)(d_ + 2 * ATB64 + (32 * e_) * AKP) = vS[e_]; } } while (0)
#define A6_BAR() do { asm volatile("s_waitcnt lgkmcnt(0)" ::: "memory"); __builtin_amdgcn_s_barrier(); asm volatile("" ::: "memory"); } while (0)
    A6_LOAD(ka_, va_, 0); A6_STORE(ka_, va_, 0);
    A6_LOAD(ka_, va_, 1);
    A6_BAR();
#define A6_ITER(kt, kSt, vSt, kLd, vLd) do { \
        A6_LOAD(kLd, vLd, (kt) + 2); \
        attn_tile64<DVT>(O, m_run, l_run, qf, lds + ((kt) & 1) * ATB64 + koffb, lds + (2 + ((kt) & 1)) * ATB64, lane); \
        if ((kt) + 1 < nt) A6_STORE(kSt, vSt, ((kt) + 1) & 1); \
        A6_BAR(); } while (0)
#pragma nounroll
    for (int kt = 0; kt < nt; kt += 2) {
        A6_ITER(kt, ka_, va_, kb_, vb_);
        if (kt + 1 < nt) A6_ITER(kt + 1, kb_, vb_, ka_, va_);
    }
#undef A6_ITER
#undef A6_LOAD
#undef A6_STORE
#undef A6_BAR
}
DEVI void load_q(bf16x8 (&qf)[4], const bf16* Qb, int ldq, int lane) {
    const int r = lane & 31, h = lane >> 5;
#pragma unroll
    for (int ks = 0; ks < 4; ++ks) qf[ks] = *(const bf16x8*)(Qb + (size_t)r * ldq + 16 * ks + 8 * h);
}
template <int DVT> DEVI void zero_o(f32x16 (&O)[DVT]) {
#pragma unroll
    for (int dt = 0; dt < DVT; ++dt)
#pragma unroll
        for (int i = 0; i < 16; ++i) O[dt][i] = 0.f;
}
template <int DVT> DEVI void store_o(const f32x16 (&O)[DVT], float scale, bf16* out, int lane) {
    const int r = lane & 31, h = lane >> 5;
#pragma unroll
    for (int dt = 0; dt < DVT; ++dt)
#pragma unroll
        for (int g = 0; g < 4; ++g) { v2u w; w.x = pk2(O[dt][4 * g] * scale, O[dt][4 * g + 1] * scale); w.y = pk2(O[dt][4 * g + 2] * scale, O[dt][4 * g + 3] * scale);
            *(v2u*)(out + (size_t)r * D + 32 * dt + 8 * g + 4 * h) = w; }
}
DEVI void diff_combine(f32x16 (&O)[4], float inv_l, bool second, LAS float* xch, float lam, float lam_init, const float* dnw, bf16* out, int lane) {
    if (second) {
#pragma unroll
        for (int dt = 0; dt < 4; ++dt)
#pragma unroll
            for (int i = 0; i < 16; ++i) xch[(dt * 16 + i) * 64 + lane] = O[dt][i] * inv_l;
    }
    __syncthreads();
    if (!second) {
        const int r = lane & 31, h = lane >> 5;
        float ss = 0.f;
#pragma unroll
        for (int dt = 0; dt < 4; ++dt)
#pragma unroll
            for (int i = 0; i < 16; ++i) { const float v = O[dt][i] * inv_l - lam * xch[(dt * 16 + i) * 64 + lane]; O[dt][i] = v; ss += v * v; }
        ss = xhalf_sum(ss);
        const float rs = rsqrtf(ss * (1.0f / 128.0f) + NORM_EPS) * (1.0f - lam_init);
#pragma unroll
        for (int dt = 0; dt < 4; ++dt)
#pragma unroll
            for (int g = 0; g < 4; ++g) { const int dv = 32 * dt + 8 * g + 4 * h; const f32x4 nw = *(const f32x4*)(dnw + dv);
                v2u w; w.x = pk2(O[dt][4 * g] * rs * nw.x, O[dt][4 * g + 1] * rs * nw.y); w.y = pk2(O[dt][4 * g + 2] * rs * nw.z, O[dt][4 * g + 3] * rs * nw.w);
                *(v2u*)(out + (size_t)r * D + dv) = w; }
    }
    __syncthreads();
}
DEVI void o2_phase(const OddPtrs& P, bf16* MIXO, LAS unsigned char* lds, int blk, int tid, int wave, int lane) {
    LAS float* xch = (LAS float*)lds + (wave & 3) * 4096;
    const bf16* UB = P.UB;
    float lam;
    { const float p01 = wave_sum(P.dlam[lane] * P.dlam[64 + lane]), p23 = wave_sum(P.dlam[128 + lane] * P.dlam[192 + lane]); lam = __expf(p01) - __expf(p23) + P.lam_init; }
    const int sub = wave >> 2, qw = wave & 3;
    {
        lane = launder_v(lane);
        const int u = blk, qt = u & 15, h8 = (u >> 4) & 7, bs = u >> 7;
        const int mq = MP + bs * 2048 + qt * 128 + qw * 32;
        bf16x8 qf[4]; load_q(qf, UB + (size_t)mq * 6144 + 3072 + h8 * 128 + sub * 64, 6144, lane);
        f32x16 O[4]; zero_o<4>(O); float m_run = -1e30f, l_run = 0.f;
        const size_t cb = (size_t)((bs * 2 + P.li) * 256) * 1024 + h8 * 128, sb = (size_t)(MP + bs * 2048) * 6144 + h8 * 128;
        attn_unit64<2, 4>(O, m_run, l_run, qf, P.CDK + cb, P.CDV + cb, 1024, 4, UB + sb + 4096, UB + sb + 5120, 6144, 32, sub * 128, lds, tid, lane);
        diff_combine(O, 1.0f / l_run, sub == 1, xch, lam, P.lam_init, P.dnw, MIXO + (size_t)mq * D + 1024 + h8 * 128, lane);
    }
#pragma nounroll
    for (int rep = 0; rep < 2; ++rep) {
        lane = launder_v(lane);
        const int u = blk * 2 + rep, qt = u & 1, h8 = (u >> 1) & 7, b = u >> 4;
        const int mq = b * 256 + qt * 128 + qw * 32;
        bf16x8 qf[4]; load_q(qf, UB + (size_t)mq * 6144 + 3072 + h8 * 128 + sub * 64, 6144, lane);
        f32x16 O[4]; zero_o<4>(O); float m_run = -1e30f, l_run = 0.f;
        const size_t sb = (size_t)(b * 256) * 6144 + h8 * 128;
        attn_unit64<2, 4>(O, m_run, l_run, qf, UB + sb + 4096, UB + sb + 5120, 6144, 4, UB, UB, 6144, 0, sub * 128, lds, tid, lane);
        diff_combine(O, 1.0f / l_run, sub == 1, xch, lam, P.lam_init, P.dnw, MIXO + (size_t)mq * D + 1024 + h8 * 128, lane);
    }
    {
        lane = launder_v(lane);
        const int u = blk, g = u & 7, hd = (u >> 3) & 15, bs = u >> 7;
        const int gr = 4 * g + (wave >> 1), qh = wave & 1;
        const int mq = MP + bs * 2048 + gr * 64 + qh * 32;
        bf16x8 qf[4]; load_q(qf, UB + (size_t)mq * 6144 + hd * 64, 6144, lane);
        f32x16 O[2]; zero_o<2>(O); float m_run = -1e30f, l_run = 0.f;
        int kmin = 4 * g - 4; kmin = kmin < 0 ? 0 : (kmin > 24 ? 24 : kmin);
        int kmax = 4 * g + 3 - 4; kmax = (kmax < 0 ? 0 : (kmax > 24 ? 24 : kmax)) + 7;
        const size_t cb = (size_t)((bs * 2 + P.li) * 256) * 1024 + hd * 64, sb = (size_t)(MP + bs * 2048 + kmin * 64) * 6144 + hd * 64;
        LAS float* rpl = (LAS float*)(lds + 102400);
        if (tid < 465) rpl[tid] = P.rpb[hd * (15 * 31) + tid];
        __syncthreads();
        attn_unit<1, 2>(O, m_run, l_run, qf, P.CNK + cb, P.CNV + cb, 1024, 8, UB + sb + 1024, UB + sb + 2048, 6144, (kmax - kmin + 1) * 2, 0, 1, kmin, gr, qh * 32 + (lane & 31), rpl, lds, tid, lane);
        store_o<2>(O, 1.0f / l_run, MIXO + (size_t)mq * D + hd * 64, lane);
    }
#pragma nounroll
    for (int rep = 0; rep < 2; ++rep) {
        lane = launder_v(lane);
        const int u = blk * 2 + rep, hd = u & 15, b = u >> 4;
        const int mq = b * 256 + wave * 32;
        bf16x8 qf[4]; load_q(qf, UB + (size_t)mq * 6144 + hd * 64, 6144, lane);
        f32x16 O[2]; zero_o<2>(O); float m_run = -1e30f, l_run = 0.f;
        const size_t sb = (size_t)(b * 256) * 6144 + hd * 64;
        attn_unit64<1, 2>(O, m_run, l_run, qf, UB + sb + 1024, UB + sb + 2048, 6144, 4, UB, UB, 6144, 0, 0, lds, tid, lane);
        store_o<2>(O, 1.0f / l_run, MIXO + (size_t)mq * D + hd * 64, lane);
    }
}

constexpr int CW_BAR = 4096;
constexpr int PO_NORM = 0, PO_MU = 49152, PO_W0 = 56128, PO_A0 = 60224, PO_KK = 64320, PO_KA = 66368, PO_RK = 68416, PO_LNW = 70464, PO_LNB = 72512, PO_LB = 74560,
              PO_HGNW = 78656, PO_RPB = 80704, PO_DLAM = 95584, PO_DNW = 96096, PO_END = 96352;
static_assert(WS_PAR + (size_t)PO_END * 4 <= WS_MOD, "parameter block");
DEVI KGAS unsigned char* launder(KGAS unsigned char* p) { asm volatile("" : "+s"(p)); return p; }
DEVI void copy_f32(const float* src, float* dst, int n, int gtid, int NT) { for (int i = gtid; i < n; i += NT) dst[i] = src[i]; }

__global__ void __launch_bounds__(NTHR, 2) fwd_kernel(Args a) {
    extern __shared__ __attribute__((aligned(16))) unsigned char lds_raw[];
    LAS unsigned char* lds = (LAS unsigned char*)lds_raw;
    const int tid0 = threadIdx.x, blk0 = blockIdx.x, G = gridDim.x;
#define PHASE_PRE KGAS unsigned char* ws = launder(a.ws); const int tid = launder_v(tid0), blk = launder_i(blk0), lane = tid & 63, wave = __builtin_amdgcn_readfirstlane(tid >> 6), \
        gw = blk * NWAVES + wave, NGW = G * NWAVES, gtid = blk * NTHR + tid, NT = G * NTHR; (void)ws; (void)lane; (void)gw; (void)NGW; (void)gtid; (void)NT;
#define WSRC(W) WSrc W; W.w1 = a.in[13]; W.w2 = a.in[14]; W.evin = a.in[15]; W.evout = a.in[16]; W.odin = a.in[30]; W.odout = a.in[31]; W.rw2 = a.in[19]; W.ra2 = a.in[21]; W.rg2 = a.in[22];
#define CONV_CTR(l_) ((unsigned*)(ws + WS_CTL) + 9216 + 64 * ((l_) + 1))
#define CONV_TAIL(S_) do { const int rounds_ = (S_.nwg + G - 1) / G; if ((S_.nwg % G) != 0 && (rounds_ - 1) * G + blk >= S_.nwg) { WSRC(W_); convert_tail(W_, ws, l, CONV_CTR(l), 9, 1 << 30, lds, tid, wave, lane); } } while (0)
    for (int u = tid0; u < (LDS_BYTES - LDSCTL_OFF) / 4; u += NTHR) ((LAS unsigned*)(lds + LDSCTL_OFF))[u] = 0u;
    __syncthreads();
    volatile LAS unsigned* MISC = (volatile LAS unsigned*)(lds + MISC_OFF);
    (void)xcd_barrier_post((unsigned*)(a.ws + WS_CTL) + CW_BAR, MISC + 8);
#define GRID_BAR() do { XcdBarrier bar_; bar_.bar = (unsigned*)(launder(a.ws) + WS_CTL) + CW_BAR; bar_.x = xb_xcc_id(); bar_.st = (volatile LAS unsigned*)(lds + MISC_OFF) + 8; xcd_barrier(bar_); } while (0)

    {
        PHASE_PRE
        float* MOD = (float*)(ws + WS_MOD); float* ROPE = (float*)(ws + WS_ROPE); float* PAR = (float*)(ws + WS_PAR);
        if (gtid == 0) { const float** pt_ = (const float**)(ws + WS_PTRS); pt_[0] = a.in[9]; pt_[1] = a.in[2]; pt_[2] = a.in[10]; pt_[3] = a.in[11]; }
        ada_cond(a.in[9], a.in[2], (LAS float*)lds, tid);
        for (int item = blk; item < 256; item += G) ada_item(a.in[10], a.in[11], MOD, 0, item * 72, (const LAS float*)lds, (LAS float*)(lds + 24576), tid);
        if (gtid < 1024) { const int pos = gtid >> 4, pair = gtid & 15; const float inv = powf(10000.0f, -(float)pair * (1.0f / 16.0f)); float sn, cs; sincosf((float)pos * inv, &sn, &cs); ROPE[gtid * 2] = cs; ROPE[gtid * 2 + 1] = sn; }
        copy_f32(a.in[12], PAR + PO_NORM, 49152, gtid, NT); copy_f32(a.in[17], PAR + PO_MU, 6976, gtid, NT); copy_f32(a.in[18], PAR + PO_W0, 4096, gtid, NT); copy_f32(a.in[20], PAR + PO_A0, 4096, gtid, NT);
        copy_f32(a.in[23], PAR + PO_KK, 2048, gtid, NT); copy_f32(a.in[24], PAR + PO_KA, 2048, gtid, NT); copy_f32(a.in[25], PAR + PO_RK, 2048, gtid, NT); copy_f32(a.in[26], PAR + PO_LNW, 2048, gtid, NT);
        copy_f32(a.in[27], PAR + PO_LNB, 2048, gtid, NT); copy_f32(a.in[28], PAR + PO_LB, 4096, gtid, NT); copy_f32(a.in[29], PAR + PO_HGNW, 2048, gtid, NT); copy_f32(a.in[32], PAR + PO_RPB, 14880, gtid, NT);
        copy_f32(a.in[33], PAR + PO_DLAM, 512, gtid, NT); copy_f32(a.in[34], PAR + PO_DNW, 256, gtid, NT);
        for (int q = 0; q < 4; ++q) { const float* src = a.in[5 + q]; bf16* dst = (bf16*)(ws + WS_CCH) + (size_t)q * 1048576;
            for (int i = gtid; i < 262144; i += NT) { const f32x4 v = *(const f32x4*)(src + 4 * (size_t)i); v2u o; o.x = pk2(v.x, v.y); o.y = pk2(v.z, v.w); *(v2u*)(dst + 4 * (size_t)i) = o; } }
        __syncthreads();
        { WSRC(W); convert_tail(W, ws, -1, CONV_CTR(-1), 1 << 30, 1 << 30, lds, tid, wave, lane); }
    }
    GRID_BAR();
    { PHASE_PRE const float* MOD = (const float*)(ws + WS_MOD); const float* nw = (const float*)(ws + WS_PAR) + PO_NORM;
      row_phase<false, true, false, true>(a.in[0], a.in[1], nullptr, (bf16*)(ws + WS_X), (bf16*)(ws + WS_H), 0.f, MOD, 0, nw, MOD, 0, nw, lds, tid, gw, lane); }
    GRID_BAR();

#pragma nounroll
    for (int l = 0; l < 4; ++l) {
        const int li = l >> 1;
        { PHASE_PRE
          pg8::Gemm g{(const bf16*)(ws + WS_H), (const bf16*)(ws + WS_W1T) + (size_t)(l * 2) * NF1 * D, M, NF1, D, D}; pg8::StaticOrder S; S.init(M, NF1, G, blk); pg8::EpiSwiglu E{(bf16*)(ws + WS_ACT), FF};
          pg8::gemm_phase<pg8::EpiSwiglu, pg8::StaticOrder, true, true>(lds, g, S, E, tid); CONV_TAIL(S); }
        GRID_BAR();
        { PHASE_PRE
          pg8::Gemm g{(const bf16*)(ws + WS_ACT), (const bf16*)(ws + WS_W2T) + (size_t)(l * 2) * D * FF, M, D, FF, 2816}; pg8::StaticOrder S; S.init(M, D, G, blk, 2); pg8::EpiSlab E{(bf16*)(ws + WS_Y), D, (size_t)M * D};
          pg8::gemm_phase<pg8::EpiSlab, pg8::StaticOrder, true, true>(lds, g, S, E, tid); }
        GRID_BAR();
        { PHASE_PRE bf16* X = (bf16*)(ws + WS_X); const float* modl = (const float*)(ws + WS_MOD) + (size_t)l * 3 * NMOD; const float* nwl = (const float*)(ws + WS_PAR) + PO_NORM + (size_t)l * 6 * D;
          row_phase<true, true, true, true>(X, X + (size_t)MP * D, (const bf16*)(ws + WS_Y), X, (bf16*)(ws + WS_H), 0.5f, modl, 2, nwl + 1 * D, modl, 3, nwl + 2 * D, lds, tid, gw, lane); }
        GRID_BAR();
        if ((l & 1) == 0) { PHASE_PRE
          pg8::Gemm g{(const bf16*)(ws + WS_H), (const bf16*)(ws + WS_EVIN) + (size_t)li * EVP * D, M, EVP, D, D}; pg8::StaticOrder S; S.init(M, EVP, G, blk); pg8::EpiSlab E{(bf16*)(ws + WS_U), EVP, 0};
          pg8::gemm_phase<pg8::EpiSlab, pg8::StaticOrder, true, true>(lds, g, S, E, tid); CONV_TAIL(S); }
        else { PHASE_PRE
          pg8::Gemm g{(const bf16*)(ws + WS_H), (const bf16*)(ws + WS_ODIN) + (size_t)li * ODC * D, M, ODC, D, D}; pg8::StaticOrder S; S.init(M, ODC, G, blk);
          pg8::EpiOdd E{(bf16*)(ws + WS_UB), (const float*)(ws + WS_ROPE), a.out + OUT_NK, a.out + OUT_NV, a.out + OUT_DK, a.out + OUT_DV, li, QSCALE};
          pg8::gemm_phase<pg8::EpiOdd, pg8::StaticOrder, true, true>(lds, g, S, E, tid); CONV_TAIL(S); }
        GRID_BAR();
        if ((l & 1) == 0) {
#define EVEN_PTRS(P) EvenPtrs P; { KGAS unsigned char* ws = launder(a.ws); const float* PAR = (const float*)(ws + WS_PAR); \
            P.U = (const bf16*)(ws + WS_U); P.LR = (const bf16*)(ws + WS_LR); \
            P.RWV = (float*)(ws + WS_RWV); P.BONUS = (float*)(ws + WS_RWR); P.RWO = (float*)(ws + WS_RWO); P.HGO = (float*)(ws + WS_HGO); \
            P.mu = PAR + PO_MU + li * ACOLS; P.w0 = PAR + PO_W0 + li * 2048; P.a0 = PAR + PO_A0 + li * 2048; P.kk_w = PAR + PO_KK + li * 1024; P.ka_w = PAR + PO_KA + li * 1024; \
            P.r_k = PAR + PO_RK + li * 1024; P.ln_w = PAR + PO_LNW + li * 1024; P.ln_b = PAR + PO_LNB + li * 1024; P.lb0 = PAR + PO_LB; P.lb1 = PAR + PO_LB + 2048; P.hg_nw = PAR + PO_HGNW + li * 1024; P.li = li; }
            { PHASE_PRE e1a_phase((const bf16*)(ws + WS_U), (const float*)(ws + WS_PAR) + PO_MU + li * ACOLS, (bf16*)(ws + WS_L), gtid, NT); }
            GRID_BAR();
            { PHASE_PRE
              pg8::Gemm g{(const bf16*)(ws + WS_L), (const bf16*)(ws + WS_LRW) + (size_t)li * 5120 * LK, M, 5120, LK, -1}; pg8::StaticOrder S; S.init(M, 5120, G, blk); pg8::EpiSlab E{(bf16*)(ws + WS_LR), 5120, 0};
              pg8::gemm_phase<pg8::EpiSlab, pg8::StaticOrder, true, true>(lds, g, S, E, tid); }
            GRID_BAR();
            { PHASE_PRE EVEN_PTRS(P); e2_phase(P, a.in[3], a.in[4], a.out + OUT_SRW, a.out + OUT_SHG, (unsigned*)(ws + WS_CTL) + 8192 + 64 * li, lds, tid, wave, lane); }
            GRID_BAR();
            { PHASE_PRE EVEN_PTRS(P); e3_phase(P, (bf16*)(ws + WS_MIXO), gw, NGW, lane); }
            GRID_BAR();
        } else {
#define ODD_PTRS(P) OddPtrs P; { KGAS unsigned char* ws = launder(a.ws); const float* PAR = (const float*)(ws + WS_PAR); const bf16* CCH = (const bf16*)(ws + WS_CCH); \
            P.UB = (const bf16*)(ws + WS_UB); P.CNK = CCH; P.CNV = CCH + 1048576; P.CDK = CCH + 2 * 1048576; P.CDV = CCH + 3 * 1048576; \
            P.rpb = PAR + PO_RPB + li * 16 * 15 * 31; P.dlam = PAR + PO_DLAM + li * 256; P.dnw = PAR + PO_DNW + li * 128; \
            P.li = li; P.lam_init = 0.8f - 0.6f * __expf(-0.3f * (float)l); }
            { PHASE_PRE ODD_PTRS(P); o2_phase(P, (bf16*)(ws + WS_MIXO), lds, blk, tid, wave, lane); }
            GRID_BAR();
        }
        { PHASE_PRE
          const bf16* Bt = (l & 1) ? (const bf16*)(ws + WS_ODOUT) + (size_t)li * D * D : (const bf16*)(ws + WS_EVOUT) + (size_t)li * D * D;
          pg8::Gemm g{(const bf16*)(ws + WS_MIXO), Bt, M, D, D, 1024}; pg8::StaticOrder S; S.init(M, D, G, blk, 2); pg8::EpiSlab E{(bf16*)(ws + WS_Y), D, (size_t)M * D};
          pg8::gemm_phase<pg8::EpiSlab, pg8::StaticOrder, true, true>(lds, g, S, E, tid); }
        GRID_BAR();
        { PHASE_PRE bf16* X = (bf16*)(ws + WS_X); const float* modl = (const float*)(ws + WS_MOD) + (size_t)l * 3 * NMOD; const float* nwl = (const float*)(ws + WS_PAR) + PO_NORM + (size_t)l * 6 * D;
          { WSRC(W_); convert_tail(W_, ws, l, CONV_CTR(l), 1 << 30, list_w1b_end(l), lds, tid, wave, lane); }
          row_phase<true, true, true, true>(X, X + (size_t)MP * D, (const bf16*)(ws + WS_Y), X, (bf16*)(ws + WS_H), 1.0f, modl, 5, nwl + 3 * D, modl, 6, nwl + 4 * D, lds, tid, gw, lane); }
        GRID_BAR();
        { PHASE_PRE
          pg8::Gemm g{(const bf16*)(ws + WS_H), (const bf16*)(ws + WS_W1T) + (size_t)(l * 2 + 1) * NF1 * D, M, NF1, D, D}; pg8::StaticOrder S; S.init(M, NF1, G, blk); pg8::EpiSwiglu E{(bf16*)(ws + WS_ACT), FF};
          pg8::gemm_phase<pg8::EpiSwiglu, pg8::StaticOrder, true, true>(lds, g, S, E, tid); CONV_TAIL(S); }
        GRID_BAR();
        { PHASE_PRE
          pg8::Gemm g{(const bf16*)(ws + WS_ACT), (const bf16*)(ws + WS_W2T) + (size_t)(l * 2 + 1) * D * FF, M, D, FF, 2816}; pg8::StaticOrder S; S.init(M, D, G, blk, 2); pg8::EpiSlab E{(bf16*)(ws + WS_Y), D, (size_t)M * D};
          pg8::gemm_phase<pg8::EpiSlab, pg8::StaticOrder, true, true>(lds, g, S, E, tid); }
        GRID_BAR();
        { PHASE_PRE bf16* X = (bf16*)(ws + WS_X); const float* modl = (const float*)(ws + WS_MOD) + (size_t)l * 3 * NMOD; const float* nwl = (const float*)(ws + WS_PAR) + PO_NORM + (size_t)l * 6 * D;
          { WSRC(W_); convert_tail(W_, ws, l, CONV_CTR(l), 1 << 30, 1 << 30, lds, tid, wave, lane); }
          if (l < 3) row_phase<true, true, true, true>(X, X + (size_t)MP * D, (const bf16*)(ws + WS_Y), X, (bf16*)(ws + WS_H), 0.5f, modl, 8, nwl + 5 * D, modl + 3 * NMOD, 0, nwl + 6 * D, lds, tid, gw, lane);
          else row_phase<true, false, true, false>(X, X + (size_t)MP * D, (const bf16*)(ws + WS_Y), a.out + OUT_Y, nullptr, 0.5f, modl, 8, nwl + 5 * D, modl, 0, nwl, lds, tid, gw, lane); }
        if (l < 3) GRID_BAR();
    }
#undef GRID_BAR
}

extern "C" void kernel_launch(void* const* d_in, const int* in_sizes, int n_in, void* d_out, int out_size, void* d_ws, size_t ws_size, hipStream_t stream) {
    static int grid = 0;
    if (grid == 0) {
        if (n_in != 35 || (size_t)out_size != OUT_TOTAL || ws_size < WS_END) { fprintf(stderr, "kernel_launch: unexpected problem (n_in %d, out %d, ws %zu; need ws >= %zu)\n", n_in, out_size, ws_size, (size_t)WS_END); grid = -1; return; }
        int dev = 0, cus = 0, per_cu = 0;
        if (hipGetDevice(&dev) != hipSuccess || hipDeviceGetAttribute(&cus, hipDeviceAttributeMultiprocessorCount, dev) != hipSuccess) { grid = -1; return; }
        if (hipFuncSetAttribute((const void*)fwd_kernel, hipFuncAttributeMaxDynamicSharedMemorySize, LDS_BYTES) != hipSuccess) { fprintf(stderr, "kernel_launch: hipFuncSetAttribute failed\n"); grid = -1; return; }
        if (hipOccupancyMaxActiveBlocksPerMultiprocessor(&per_cu, (const void*)fwd_kernel, NTHR, LDS_BYTES) != hipSuccess || per_cu < 1) fprintf(stderr, "kernel_launch: occupancy query reports %d\n", per_cu);
        (void)hipGetLastError();
        if (cus != 256) fprintf(stderr, "kernel_launch: built for 256 CUs, device reports %d\n", cus);
        grid = 256;
    }
    if (grid < 0) return;
    (void)hipMemsetAsync((char*)d_ws + WS_CTL, 0, CTL_ZERO_BYTES, stream);
    Args a{};
    for (int i = 0; i < 35; ++i) a.in[i] = (const KGAS float*)d_in[i];
    a.out = (KGAS float*)d_out; a.ws = (KGAS unsigned char*)d_ws;
    hipLaunchKernelGGL(fwd_kernel, dim3(grid), dim3(NTHR), LDS_BYTES, stream, a);
}
```

```cpp
#include <hip/hip_runtime.h>
#include <cstdio>
#include <cstdint>

namespace pg8 {
#define PG8_LAS __attribute__((address_space(3)))
typedef unsigned short bf16_t;
typedef short bf16x8 __attribute__((ext_vector_type(8)));
typedef float f32x4 __attribute__((ext_vector_type(4)));
typedef unsigned u32x4 __attribute__((ext_vector_type(4)));
constexpr int BM = 256, BK = 64, HALF = 128, HTB = HALF * BK * 2, STAGE_BYTES = 8 * HTB, NXCD = 8, WGM = 4;

__host__ __device__ __forceinline__ int lds_byte(int r, int c) { const int st = (r >> 4) * 2 + (c >> 5), rr = r & 15, cc = c & 31, ob = rr * 64 + cc * 2; return st * 1024 + (ob ^ (((ob >> 9) & 1) << 5)); }
__host__ __device__ __forceinline__ void stage_rc(int b, int& R, int& C) { const int st = b / 1024, sb = b % 1024, swz = sb ^ (((sb >> 9) & 1) << 5); R = (st >> 1) * 16 + swz / 64; C = (st & 1) * 32 + (swz % 64) / 2; }
__host__ __device__ __forceinline__ int perm32(int rho) { const int n = rho >> 4, i = rho & 15; return 8 * (i >> 2) + 4 * n + (i & 3); }

struct Unit { int pm, pn, ks; };
struct Gemm { const bf16_t* A; const bf16_t* Bt; int M, N, K, kb1; };
__device__ __forceinline__ int unit_kbeg(const Gemm& g, const Unit& u) { return g.kb1 < 0 ? 128 * (u.pn >> 2) : (u.ks ? g.kb1 : 0); }
__device__ __forceinline__ int unit_nt(const Gemm& g, const Unit& u) { return g.kb1 < 0 ? (((u.pn >> 2) == 4) ? 4 : 2) : ((u.ks ? (g.K - g.kb1) : g.kb1) / BK); }

struct StaticOrder {
    int nM, nN, nwg, G, c, nN0;
    __host__ __device__ void init(int M, int N, int G_, int c_, int nsplit = 1) { nM = M / BM; nN0 = N / BM; nN = nN0 * nsplit; nwg = nM * nN; G = G_; c = c_; }
    __host__ __device__ bool next(int i, Unit& u) const {
        const long L = (long)i * G + c; if (L >= nwg) return false;
        int wgid = (int)L; { const int q = nwg / NXCD, r = nwg % NXCD, xcd = wgid % NXCD, off = wgid / NXCD; wgid = (xcd < r ? xcd * (q + 1) : r * (q + 1) + (xcd - r) * q) + off; }
        const int nig = WGM * nN, gid = wgid / nig, fm = gid * WGM, gsz = (nM - fm) < WGM ? (nM - fm) : WGM;
        u.pm = fm + ((wgid % nig) % gsz); const int pne = (wgid % nig) / gsz; u.ks = pne / nN0; u.pn = pne - u.ks * nN0; return true;
    }
    __device__ __forceinline__ void a_ready(const Unit&) const {}
    __device__ __forceinline__ void done(const Unit&) const {}
};

__device__ __forceinline__ unsigned cvt_pk_bf16(float lo, float hi) { unsigned r; asm volatile("v_cvt_pk_bf16_f32 %0, %1, %2" : "=v"(r) : "v"(lo), "v"(hi)); return r; }

struct EpiF32 {
    static constexpr bool PERM = false, AFTER_DRAIN = false;
    float* C; int ldc;
    __device__ __forceinline__ void operator()(const f32x4 (&acc)[2][2][4][2], const Unit& u, int wr, int wc, int fr, int fq) const {
        const int row0 = u.pm * BM + wr * 64 + fr, col0 = u.pn * BM + wc * 32 + 4 * fq;
#pragma unroll
        for (int ai = 0; ai < 2; ++ai)
#pragma unroll
            for (int m = 0; m < 4; ++m) { float* rowp = C + (size_t)(row0 + ai * HALF + m * 16) * ldc + col0;
#pragma unroll
                for (int bj = 0; bj < 2; ++bj)
#pragma unroll
                    for (int n = 0; n < 2; ++n) *(f32x4*)(rowp + bj * HALF + n * 16) = acc[ai][bj][m][n]; }
    }
};
struct EpiSlab {
    static constexpr bool PERM = true, AFTER_DRAIN = false;
    bf16_t* O; int ldc; size_t slab;
    __device__ __forceinline__ void operator()(const f32x4 (&acc)[2][2][4][2], const Unit& u, int wr, int wc, int fr, int fq) const {
        const int row0 = u.pm * BM + wr * 64 + fr, col0 = u.pn * BM + wc * 32 + 8 * fq;
        bf16_t* base = O + (u.ks ? slab : 0);
#pragma unroll
        for (int ai = 0; ai < 2; ++ai)
#pragma unroll
            for (int m = 0; m < 4; ++m) { bf16_t* rowp = base + (size_t)(row0 + ai * HALF + m * 16) * ldc + col0;
#pragma unroll
                for (int bj = 0; bj < 2; ++bj) { const f32x4 v0 = acc[ai][bj][m][0], v1 = acc[ai][bj][m][1];
                    u32x4 w; w.x = cvt_pk_bf16(v0[0], v0[1]); w.y = cvt_pk_bf16(v0[2], v0[3]); w.z = cvt_pk_bf16(v1[0], v1[1]); w.w = cvt_pk_bf16(v1[2], v1[3]);
                    *(u32x4*)(rowp + bj * HALF) = w; } }
    }
};
struct EpiSwiglu {
    static constexpr bool PERM = true, AFTER_DRAIN = false;
    bf16_t* O; int ldc;
    __device__ __forceinline__ void operator()(const f32x4 (&acc)[2][2][4][2], const Unit& u, int wr, int wc, int fr, int fq) const {
        const int row0 = u.pm * BM + wr * 64 + fr, col0 = u.pn * HALF + wc * 32 + 8 * fq;
#pragma unroll
        for (int ai = 0; ai < 2; ++ai)
#pragma unroll
            for (int m = 0; m < 4; ++m) { bf16_t* rowp = O + (size_t)(row0 + ai * HALF + m * 16) * ldc + col0;
                float r[8];
#pragma unroll
                for (int n = 0; n < 2; ++n)
#pragma unroll
                    for (int j = 0; j < 4; ++j) { const float g = acc[ai][0][m][n][j], up = acc[ai][1][m][n][j];
                        r[n * 4 + j] = g * __builtin_amdgcn_rcpf(1.0f + __expf(-g)) * up; }
                u32x4 w; w.x = cvt_pk_bf16(r[0], r[1]); w.y = cvt_pk_bf16(r[2], r[3]); w.z = cvt_pk_bf16(r[4], r[5]); w.w = cvt_pk_bf16(r[6], r[7]);
                *(u32x4*)rowp = w; }
    }
};

struct EpiOdd {
    static constexpr bool PERM = false, AFTER_DRAIN = false;
    bf16_t* UB; const float* rope; float* onk; float* onv; float* odk; float* odv; int li; float qscale;
    __device__ __forceinline__ void operator()(const f32x4 (&acc)[2][2][4][2], const Unit& u, int wr, int wc, int fr, int fq) const {
        const int colt = u.pn * BM, type = colt >> 10;
        const bool smp = u.pm >= 32, dorope = smp && (type == 3 || type == 4);
        const float sc = (type == 0 || type == 3) ? qscale : 1.0f;
        float* fo = smp ? nullptr : (type == 1 ? onk : type == 2 ? onv : type == 4 ? odk : type == 5 ? odv : nullptr);
        const int row0 = u.pm * BM + wr * 64 + fr, col0 = colt + wc * 32 + 4 * fq;
#pragma unroll
        for (int ai = 0; ai < 2; ++ai)
#pragma unroll
            for (int m = 0; m < 4; ++m) {
                const int r = row0 + ai * HALF + m * 16;
                f32x4 cs0 = {1.f, 0.f, 1.f, 0.f}, cs1 = cs0;
                if (dorope) { const int t = (r - 8192) & 2047; const int pos = (wc & 1) ? (t & 63) : (t >> 6); const float* tb = rope + (pos * 16 + 4 * fq) * 2; cs0 = *(const f32x4*)tb; cs1 = *(const f32x4*)(tb + 4); }
                const size_t orow = ((size_t)((r >> 8) * 2 + li) * 256 + (r & 255)) * 1024;
#pragma unroll
                for (int bj = 0; bj < 2; ++bj) {
                    f32x4 v0 = acc[ai][bj][m][0], v1 = acc[ai][bj][m][1];
                    const int c = col0 + bj * HALF;
                    if (fo) { *(f32x4*)(fo + orow + (c & 1023)) = v0; *(f32x4*)(fo + orow + ((c + 16) & 1023)) = v1; }
                    if (dorope) {
                        f32x4 a, b;
                        a.x = v0.x * cs0.x - v1.x * cs0.y; b.x = v1.x * cs0.x + v0.x * cs0.y;
                        a.y = v0.y * cs0.z - v1.y * cs0.w; b.y = v1.y * cs0.z + v0.y * cs0.w;
                        a.z = v0.z * cs1.x - v1.z * cs1.y; b.z = v1.z * cs1.x + v0.z * cs1.y;
                        a.w = v0.w * cs1.z - v1.w * cs1.w; b.w = v1.w * cs1.z + v0.w * cs1.w;
                        v0 = a; v1 = b;
                    }
                    v0 = v0 * sc; v1 = v1 * sc;
                    bf16_t* dp = UB + (size_t)r * 6144 + c;
                    typedef unsigned u32x2 __attribute__((ext_vector_type(2)));
                    u32x2 w0, w1; w0.x = cvt_pk_bf16(v0.x, v0.y); w0.y = cvt_pk_bf16(v0.z, v0.w); w1.x = cvt_pk_bf16(v1.x, v1.y); w1.y = cvt_pk_bf16(v1.z, v1.w);
                    *(u32x2*)dp = w0; *(u32x2*)(dp + 16) = w1;
                }
            }
    }
};

template <class Epi, class Sched, bool ALIGN_EPI = false, bool SP2 = false>
__device__ __forceinline__ void gemm_phase(PG8_LAS unsigned char* lds, const Gemm g, const Sched& S, const Epi& E, const int tid) {
    const int wid = __builtin_amdgcn_readfirstlane(tid >> 6), lane = tid & 63, wr = wid >> 2, wc = wid & 3, fr = lane & 15, fq = lane >> 4;
    const int K = g.K;
    unsigned voffA[2], voffB[2];
#pragma unroll
    for (int i = 0; i < 2; ++i) { int R, C; stage_rc(tid * 16 + i * 8192, R, C); const int Rb = Epi::PERM ? ((R & ~31) + perm32(R & 31)) : R;
        voffA[i] = (unsigned)(R * K + C) * 2u; voffB[i] = (unsigned)(Rb * K + C) * 2u; }
    const size_t kstep = (size_t)(BK * 2);
    const size_t hstep = (size_t)HALF * K * 2;
    const size_t tstep = 2 * hstep;
    const unsigned ldsw = (unsigned)wid * 1024u;
    const int aoff = lds_byte(wr * 64 + fr, fq * 8), boff = lds_byte(wc * 32 + fr, fq * 8);
#define PG8_SA(b, h) (((b) * 2 + (h)) * HTB)
#define PG8_SB(b, h) ((4 + (b) * 2 + (h)) * HTB)
#define PG8_STAGE(bufoff, gbase, voff) do { _Pragma("unroll") for (int _i = 0; _i < 2; ++_i) \
        __builtin_amdgcn_global_load_lds((const unsigned*)((const char*)(gbase) + (voff)[_i]), (PG8_LAS unsigned*)(lds + (bufoff) + ldsw + _i * 8192), 16, 0, 0); } while (0)
#define PG8_LDA(dst, b, h) do { _Pragma("unroll") for (int m = 0; m < 4; ++m) _Pragma("unroll") for (int k = 0; k < 2; ++k) dst[m][k] = *(const PG8_LAS bf16x8*)(lds + PG8_SA(b, h) + aoff + m * 2048 + k * 1024); } while (0)
#define PG8_LDB(dst, b, h) do { _Pragma("unroll") for (int n = 0; n < 2; ++n) _Pragma("unroll") for (int k = 0; k < 2; ++k) dst[n][k] = *(const PG8_LAS bf16x8*)(lds + PG8_SB(b, h) + boff + n * 2048 + k * 1024); } while (0)
#define PG8_MMA(ai, bj, At, Bt) do { __builtin_amdgcn_s_setprio(1); _Pragma("unroll") for (int m = 0; m < 4; ++m) _Pragma("unroll") for (int n = 0; n < 2; ++n) _Pragma("unroll") for (int k = 0; k < 2; ++k) \
        acc[ai][bj][m][n] = __builtin_amdgcn_mfma_f32_16x16x32_bf16(Bt[n][k], At[m][k], acc[ai][bj][m][n], 0, 0, 0); __builtin_amdgcn_s_setprio(0); } while (0)
#define PG8_WAIT_V(n) asm volatile("s_waitcnt vmcnt(" #n ")" ::: "memory")
#define PG8_WAIT_L(n) asm volatile("s_waitcnt lgkmcnt(" #n ")" ::: "memory")
#define PG8_BAR __builtin_amdgcn_s_barrier()
#define PG8_SCHED __builtin_amdgcn_sched_barrier(0)
    Unit cur, nxt; int ui = 0;
    if (!S.next(0, cur)) return;
    f32x4 acc[2][2][4][2];
#pragma unroll
    for (int a = 0; a < 2; ++a)
#pragma unroll
        for (int b = 0; b < 2; ++b)
#pragma unroll
            for (int m = 0; m < 4; ++m)
#pragma unroll
                for (int n = 0; n < 2; ++n) acc[a][b][m][n] = (f32x4){0.f, 0.f, 0.f, 0.f};
    bf16x8 At[4][2], B0[2][2], B1[2][2];
    const char* cA = (const char*)g.A + (size_t)cur.pm * tstep + (size_t)unit_kbeg(g, cur) * 2; const char* cB = (const char*)g.Bt + (size_t)cur.pn * tstep + (size_t)unit_kbeg(g, cur) * 2;
    int nt = unit_nt(g, cur);
    S.a_ready(cur);
    if constexpr (SP2) {
        PG8_STAGE(PG8_SB(0, 0), cB, voffB); PG8_STAGE(PG8_SB(0, 1), cB + hstep, voffB); PG8_STAGE(PG8_SA(0, 0), cA, voffA); PG8_STAGE(PG8_SA(0, 1), cA + hstep, voffA);
        if (wr == 1) PG8_BAR;
        PG8_WAIT_V(2); PG8_BAR;
        PG8_STAGE(PG8_SB(1, 0), cB + kstep, voffB); PG8_STAGE(PG8_SA(1, 0), cA + kstep, voffA); PG8_STAGE(PG8_SB(1, 1), cB + hstep + kstep, voffB);
        PG8_WAIT_V(6); PG8_BAR;
    } else {
        PG8_STAGE(PG8_SB(0, 0), cB, voffB); PG8_STAGE(PG8_SA(0, 0), cA, voffA); PG8_STAGE(PG8_SB(0, 1), cB + hstep, voffB); PG8_STAGE(PG8_SA(0, 1), cA + hstep, voffA);
        if (wr == 1) PG8_BAR;
        PG8_WAIT_V(4); PG8_BAR;
        PG8_STAGE(PG8_SB(1, 0), cB + kstep, voffB); PG8_STAGE(PG8_SA(1, 0), cA + kstep, voffA); PG8_STAGE(PG8_SB(1, 1), cB + hstep + kstep, voffB);
        PG8_WAIT_V(6); PG8_BAR;
    }
    for (;;) {
        const bool has_next = S.next(ui + 1, nxt);
        const size_t nko = has_next ? (size_t)unit_kbeg(g, nxt) * 2 : 0;
        const char* nA = has_next ? (const char*)g.A + (size_t)nxt.pm * tstep + nko : cA; const char* nB = has_next ? (const char*)g.Bt + (size_t)nxt.pn * tstep + nko : cB;
        for (int t = 0; t < nt; t += 2) {
            const bool last = (t == nt - 2);
            const char* a1 = cA + (size_t)(t + 1) * kstep;
            const char* a2 = last ? nA : cA + (size_t)(t + 2) * kstep; const char* b2 = last ? nB : cB + (size_t)(t + 2) * kstep;
            const char* a3 = a2 + kstep; const char* b3 = b2 + kstep;
            if (last && has_next) S.a_ready(nxt);
            if constexpr (SP2) {
            PG8_LDB(B0, 0, 0); PG8_LDB(B1, 0, 1); PG8_SCHED; PG8_LDA(At, 0, 0); PG8_STAGE(PG8_SA(1, 1), a1 + hstep, voffA);
            PG8_WAIT_V(8); PG8_WAIT_L(0); PG8_BAR; PG8_MMA(0, 0, At, B0); PG8_MMA(0, 1, At, B1); PG8_BAR; PG8_SCHED;
            PG8_LDA(At, 0, 1); PG8_STAGE(PG8_SB(0, 0), b2, voffB); PG8_STAGE(PG8_SB(0, 1), b2 + hstep, voffB); PG8_STAGE(PG8_SA(0, 0), a2, voffA);
            PG8_WAIT_V(8); PG8_WAIT_L(0); PG8_BAR; PG8_MMA(1, 0, At, B0); PG8_MMA(1, 1, At, B1); PG8_BAR; PG8_SCHED;
            PG8_LDB(B0, 1, 0); PG8_LDB(B1, 1, 1); PG8_SCHED; PG8_LDA(At, 1, 0); PG8_STAGE(PG8_SA(0, 1), a2 + hstep, voffA);
            PG8_WAIT_V(8); PG8_WAIT_L(0); PG8_BAR; PG8_MMA(0, 0, At, B0); PG8_MMA(0, 1, At, B1); PG8_BAR; PG8_SCHED;
            PG8_LDA(At, 1, 1); PG8_STAGE(PG8_SB(1, 0), b3, voffB); PG8_STAGE(PG8_SB(1, 1), b3 + hstep, voffB); PG8_STAGE(PG8_SA(1, 0), a3, voffA);
            PG8_WAIT_V(8); PG8_WAIT_L(0); PG8_BAR; PG8_MMA(1, 0, At, B0); PG8_MMA(1, 1, At, B1); PG8_BAR; PG8_SCHED;
            } else {
            PG8_LDB(B0, 0, 0); PG8_SCHED; PG8_LDA(At, 0, 0); PG8_STAGE(PG8_SA(1, 1), a1 + hstep, voffA);
            PG8_WAIT_L(8); PG8_BAR; PG8_WAIT_L(0); PG8_MMA(0, 0, At, B0); PG8_BAR; PG8_SCHED;
            PG8_LDB(B1, 0, 1); PG8_STAGE(PG8_SB(0, 0), b2, voffB);
            PG8_BAR; PG8_WAIT_L(0); PG8_MMA(0, 1, At, B1); PG8_BAR;
            PG8_LDA(At, 0, 1); PG8_STAGE(PG8_SA(0, 0), a2, voffA);
            PG8_BAR; PG8_WAIT_L(0); PG8_MMA(1, 0, At, B0); PG8_BAR; PG8_SCHED;
            PG8_STAGE(PG8_SB(0, 1), b2 + hstep, voffB);
            PG8_WAIT_V(6); PG8_BAR; PG8_MMA(1, 1, At, B1); PG8_BAR;
            PG8_LDB(B0, 1, 0); PG8_SCHED; PG8_LDA(At, 1, 0); PG8_STAGE(PG8_SA(0, 1), a2 + hstep, voffA);
            PG8_WAIT_L(8); PG8_BAR; PG8_WAIT_L(0); PG8_MMA(0, 0, At, B0); PG8_BAR; PG8_SCHED;
            PG8_LDB(B1, 1, 1); PG8_STAGE(PG8_SB(1, 0), b3, voffB);
            PG8_BAR; PG8_WAIT_L(0); PG8_MMA(0, 1, At, B1); PG8_BAR;
            PG8_LDA(At, 1, 1); PG8_STAGE(PG8_SA(1, 0), a3, voffA);
            PG8_BAR; PG8_WAIT_L(0); PG8_MMA(1, 0, At, B0); PG8_BAR; PG8_SCHED;
            PG8_STAGE(PG8_SB(1, 1), b3 + hstep, voffB);
            PG8_WAIT_V(6); PG8_BAR; PG8_MMA(1, 1, At, B1); PG8_BAR;
            }
        }
        if constexpr (ALIGN_EPI) { if (wr == 0) PG8_BAR; }
        if constexpr (!Epi::AFTER_DRAIN) { E(acc, cur, wr, wc, fr, fq); S.done(cur); }
        if (!has_next) break;
#pragma unroll
        for (int a = 0; a < 2; ++a)
#pragma unroll
            for (int b = 0; b < 2; ++b)
#pragma unroll
                for (int m = 0; m < 4; ++m)
#pragma unroll
                    for (int n = 0; n < 2; ++n) acc[a][b][m][n] = (f32x4){0.f, 0.f, 0.f, 0.f};
        cur = nxt; cA = nA; cB = nB; ++ui; nt = unit_nt(g, cur);
        if constexpr (ALIGN_EPI) { if (wr == 1) PG8_BAR; }
    }
    PG8_WAIT_V(0);
    if constexpr (!ALIGN_EPI) { if (wr == 0) PG8_BAR; }
    PG8_BAR;
#undef PG8_SA
#undef PG8_SB
#undef PG8_STAGE
#undef PG8_LDA
#undef PG8_LDB
#undef PG8_MMA
#undef PG8_WAIT_V
#undef PG8_WAIT_L
#undef PG8_BAR
#undef PG8_SCHED
}
}

constexpr int D = 2048, MP = 8192, MS = 4096, M = MP + MS;
constexpr int FF = 5504, NF1 = 2 * FF;
constexpr int EVC = 8608, EVP = 8704, ODC = 6144, ACOLS = 3488;
constexpr int NMOD = 9 * D;
constexpr int LK = 768;
constexpr int NWAVES = 8, NTHR = 512;
constexpr float NORM_EPS = 1e-6f;
constexpr float LOG2E = 1.4426950408889634f;

constexpr size_t MiB = 1u << 20;
constexpr size_t WS_CTL = 0, CTL_ZERO_BYTES = 64 * 1024;
constexpr size_t WS_PAR   = 64 * 1024;
constexpr size_t WS_PTRS  = 512 * 1024;
constexpr size_t WS_MOD   = 1 * MiB;
constexpr size_t WS_ROPE  = WS_MOD + 960 * 1024;
constexpr size_t WS_W1T   = 2 * MiB;
constexpr size_t WS_W2T   = WS_W1T + 344 * MiB;
constexpr size_t WS_EVIN  = WS_W2T + 172 * MiB;
constexpr size_t WS_ODIN  = WS_EVIN + 68 * MiB;
constexpr size_t WS_EVOUT = WS_ODIN + 48 * MiB;
constexpr size_t WS_ODOUT = WS_EVOUT + 16 * MiB;
constexpr size_t WS_LRW   = WS_ODOUT + 16 * MiB;
constexpr size_t WS_CCH   = WS_LRW + 16 * MiB;
constexpr size_t WS_X     = WS_CCH + 8 * MiB;
constexpr size_t WS_H     = WS_X + 96 * MiB;
constexpr size_t WS_ACT   = WS_H + 48 * MiB;
constexpr size_t WS_Y     = WS_ACT + 130 * MiB;
constexpr size_t WS_U     = WS_Y + 96 * MiB;
constexpr size_t WS_MIXO  = WS_U + 408 * MiB;
constexpr size_t WS_SCR   = WS_MIXO + 48 * MiB;
constexpr size_t A48 = (size_t)M * 1024 * 4;
constexpr size_t WS_L     = WS_SCR;
constexpr size_t WS_LR    = WS_L + 18 * MiB;
constexpr size_t WS_RWR   = WS_LR + 240 * MiB;
constexpr size_t WS_RWV   = WS_RWR + A48;
constexpr size_t WS_RWKK  = WS_RWV + A48;
constexpr size_t WS_RWW   = WS_RWKK + A48;
constexpr size_t WS_RWKD  = WS_RWW + 2 * A48;
constexpr size_t WS_RWB   = WS_RWKD + 2 * A48;
constexpr size_t WS_BONUS = WS_RWB + 2 * A48;
constexpr size_t WS_HQ    = WS_BONUS + 1 * MiB;
constexpr size_t WS_HF    = WS_HQ + A48;
constexpr size_t WS_RWO   = WS_HF + 2 * A48;
constexpr size_t WS_HGO   = WS_RWO + 2 * A48;
constexpr size_t WS_EVEN_END = WS_HGO + 2 * A48;
constexpr size_t WS_UB    = WS_SCR;
constexpr size_t WS_END   = WS_EVEN_END;
static_assert(WS_UB + (size_t)M * 6144 * 2 <= WS_END, "odd scratch inside even scratch");

constexpr size_t OUT_Y = 0, OUT_SRW = (size_t)M * D, OUT_SHG = OUT_SRW + 8388608, OUT_NK = OUT_SHG + 8388608, OUT_NV = OUT_NK + 16777216,
                 OUT_DK = OUT_NV + 16777216, OUT_DV = OUT_DK + 16777216, OUT_TOTAL = OUT_DV + 16777216;

constexpr int RING_BYTES = 131072;
constexpr int LDSCTL_OFF = RING_BYTES, MISC_OFF = LDSCTL_OFF + 320;
constexpr int LDS_BYTES = 147456;

#define GAS __attribute__((address_space(1)))
#define LAS __attribute__((address_space(3)))
#define DEVI __device__ __forceinline__
typedef unsigned short bf16;
typedef unsigned v4u __attribute__((ext_vector_type(4)));
typedef unsigned v2u __attribute__((ext_vector_type(2)));
typedef float f32x4 __attribute__((ext_vector_type(4)));
typedef float f32x2 __attribute__((ext_vector_type(2)));
typedef float f32x16 __attribute__((ext_vector_type(16)));
typedef short bf16x8 __attribute__((ext_vector_type(8)));
typedef short s16x4 __attribute__((ext_vector_type(4)));

typedef __bf16 bf16x2_t __attribute__((ext_vector_type(2)));
DEVI unsigned pk2(float lo, float hi) { f32x2 v = {lo, hi}; bf16x2_t b = __builtin_convertvector(v, bf16x2_t); return __builtin_bit_cast(unsigned, b); }
DEVI int launder_v(int x) { asm volatile("" : "+v"(x)); return x; }
DEVI int launder_i(int x) { asm volatile("" : "+s"(x)); return x; }
DEVI float sigmoidf_(float x) { return __builtin_amdgcn_rcpf(1.0f + __expf(-x)); }
DEVI float siluf_(float x) { return x * sigmoidf_(x); }
template <int CTRL> DEVI float dpp_f(float x) { return __builtin_bit_cast(float, __builtin_amdgcn_mov_dpp(__builtin_bit_cast(int, x), CTRL, 0xf, 0xf, true)); }
DEVI float sum8(float x) {
    x += dpp_f<0xB1>(x);
    x += dpp_f<0x4E>(x);
    x += dpp_f<0x141>(x);
    return x;
}
DEVI float sum16(float x) {
    x += dpp_f<0xB1>(x); x += dpp_f<0x4E>(x); x += dpp_f<0x141>(x); x += dpp_f<0x140>(x);
    return x;
}
DEVI float xrow16_sum(float x) {
    auto s = __builtin_amdgcn_permlane16_swap(__float_as_uint(x), __float_as_uint(x), false, false);
    x = __uint_as_float(s[0]) + __uint_as_float(s[1]);
    auto t = __builtin_amdgcn_permlane32_swap(__float_as_uint(x), __float_as_uint(x), false, false);
    return __uint_as_float(t[0]) + __uint_as_float(t[1]);
}
DEVI float wave_sum(float v) { return xrow16_sum(sum16(v)); }
DEVI float xhalf_max(float x) { auto rr = __builtin_amdgcn_permlane32_swap(__float_as_uint(x), __float_as_uint(x), false, false); return fmaxf(__uint_as_float(rr[0]), __uint_as_float(rr[1])); }
DEVI float xhalf_sum(float x) { auto rr = __builtin_amdgcn_permlane32_swap(__float_as_uint(x), __float_as_uint(x), false, false); return __uint_as_float(rr[0]) + __uint_as_float(rr[1]); }

#define XB_TMO      128
#define XB_XCNT(j)  (256  + 64 * (j))
#define XB_XSUB(j)  (1280 + 64 * (j))
#define XB_XGEN(j)  (2304 + 64 * (j))
#define XB_TOP      3328
#define XB_TOPGEN   3392
#define XCD_BAR_WORDS 3456
#define XB_SPIN_CAP (1u << 18)

__device__ __forceinline__ unsigned xb_ld(unsigned* p)              { return __hip_atomic_load(p, __ATOMIC_RELAXED, __HIP_MEMORY_SCOPE_AGENT); }
__device__ __forceinline__ unsigned xb_add(unsigned* p, unsigned v) { return __hip_atomic_fetch_add(p, v, __ATOMIC_RELAXED, __HIP_MEMORY_SCOPE_AGENT); }
__device__ __forceinline__ unsigned xb_xcc_id() { return (unsigned)__builtin_amdgcn_s_getreg((3 << 11) | 20) & 0xFu; }
#define XB_SPIN(cond, bar) do { unsigned _sp = 0; while (cond) { __builtin_amdgcn_s_sleep(1); \
    if ((++_sp & 255u) == 0u) { if (xb_ld(&(bar)[XB_TMO])) break; if (_sp > XB_SPIN_CAP) { atomicAdd(&(bar)[XB_TMO], 1u); break; } } } } while (0)

struct XcdBarrier { unsigned* bar; unsigned x; volatile LAS unsigned* st; };

__device__ __forceinline__ XcdBarrier xcd_barrier_post(unsigned* bar, volatile LAS unsigned* st) {
    XcdBarrier b; b.bar = bar; b.x = xb_xcc_id(); b.st = st;
    if (threadIdx.x == 0) (void)xb_add(&bar[XB_XCNT(b.x)], 1u);
    return b;
}
__device__ __forceinline__ void xcd_barrier_complete(unsigned* bar, unsigned x, unsigned& nloc, unsigned& nx) {
    const unsigned G = gridDim.x * gridDim.y * gridDim.z;
    unsigned sum, cnt, mine, sp = 0u;
    for (;;) {
        sum = 0u; cnt = 0u; mine = 0u;
#pragma unroll
        for (unsigned j = 0; j < 16; ++j) { const unsigned c = xb_ld(&bar[XB_XCNT(j)]); sum += c; cnt += (c > 0u) ? 1u : 0u; mine = (j == x) ? c : mine; }
        if (sum == G) break;
        __builtin_amdgcn_s_sleep(1);
        if ((++sp & 255u) == 0u) { if (xb_ld(&bar[XB_TMO])) break; if (sp > XB_SPIN_CAP) { atomicAdd(&bar[XB_TMO], 1u); break; } }
    }
    nloc = mine > 0u ? mine : 1u; nx = cnt > 0u ? cnt : 1u;
}
__device__ __forceinline__ void xcd_barrier(const XcdBarrier& b) {
    asm volatile("s_waitcnt vmcnt(0)" ::: "memory");
    __syncthreads();
    if (threadIdx.x == 0) {
        unsigned* bar = b.bar;
        __builtin_amdgcn_s_waitcnt(0);
        unsigned nloc = b.st[0], nx = b.st[1];
        if (nloc == 0u) { xcd_barrier_complete(bar, b.x, nloc, nx); b.st[0] = nloc; b.st[1] = nx; }
        const unsigned old = xb_add(&bar[XB_XSUB(b.x)], 1u);
        const unsigned gen = old / nloc;
        if (old + 1u == (gen + 1u) * nloc) {
            __builtin_amdgcn_fence(__ATOMIC_RELEASE, "agent");
            asm volatile("s_waitcnt vmcnt(0)" ::: "memory");
            const unsigned og = xb_add(&bar[XB_TOP], 1u);
            const unsigned tg = og / nx;
            if (og + 1u == (tg + 1u) * nx) xb_add(&bar[XB_TOPGEN], 1u);
            else XB_SPIN(xb_ld(&bar[XB_TOPGEN]) == tg, bar);
            __builtin_amdgcn_fence(__ATOMIC_ACQUIRE, "agent");
            xb_add(&bar[XB_XGEN(b.x)], 1u);
            asm volatile("s_waitcnt vmcnt(0)" ::: "memory");
        } else {
            XB_SPIN(xb_ld(&bar[XB_XGEN(b.x)]) == gen, bar);
            __builtin_amdgcn_fence(__ATOMIC_ACQUIRE, "agent");
            asm volatile("s_waitcnt vmcnt(0)" ::: "memory");
        }
    }
    __syncthreads();
}

#if defined(__HIP_DEVICE_COMPILE__)
#define KGAS GAS
#else
#define KGAS
#endif
struct Args { const KGAS float* in[35]; KGAS float* out; KGAS unsigned char* ws; };

DEVI void seq_pos(int m, int& t, int& T) { if (m < MP) { t = m & 255; T = 256; } else { t = (m - MP) & 2047; T = 2048; } }

DEVI void tr_item(const float* src, int lds_, int kvalid, bf16* dst, int ldd, LAS float* scr, int lane) {
    float v[32];
#pragma unroll
    for (int i = 0; i < 32; ++i) { const int kk = 2 * i + (lane >> 5); v[i] = (src != nullptr && kk < kvalid) ? src[(size_t)kk * lds_ + (lane & 31)] : 0.f; }
#pragma unroll
    for (int i = 0; i < 32; ++i) { const int kk = 2 * i + (lane >> 5); scr[kk * 33 + (lane & 31)] = v[i]; }
    asm volatile("s_waitcnt lgkmcnt(0)" ::: "memory");
    const int c = lane & 7;
#pragma unroll
    for (int j = 0; j < 4; ++j) { const int n = (lane >> 3) + 8 * j; const LAS float* s = scr + (8 * c) * 33 + n;
        v4u o; o.x = pk2(s[0 * 33], s[1 * 33]); o.y = pk2(s[2 * 33], s[3 * 33]); o.z = pk2(s[4 * 33], s[5 * 33]); o.w = pk2(s[6 * 33], s[7 * 33]);
        *(v4u*)(dst + (size_t)n * ldd + 8 * c) = o; }
    asm volatile("s_waitcnt lgkmcnt(0)" ::: "memory");
}
struct WSrc { const float *w1, *w2, *evin, *evout, *odin, *odout, *rw2, *ra2, *rg2; };
DEVI int layer_items(int L) { return (L & 1) ? (22016 + 11008 + 6144 + 2048) : (22016 + 11008 + 8704 + 2048 + 1920); }
DEVI void convert_layer_item(const WSrc& W, KGAS unsigned char* ws, int L, int it, LAS float* scr, int lane) {
    const int li = L >> 1;
    if (it < 22016) { const int sl = (it >= 11008) ? 1 : 0, r = it - sl * 11008, kb = r / 344, nb = r - kb * 344, n0 = nb * 32, k0 = kb * 64;
        const int pn = n0 >> 8, bj = (n0 >> 7) & 1, c = n0 & 127, ns = bj * FF + pn * 128 + c; const size_t mi = (size_t)(2 * L + sl);
        tr_item(W.w1 + mi * D * NF1 + (size_t)k0 * NF1 + ns, NF1, 64, (bf16*)(ws + WS_W1T) + mi * NF1 * D + (size_t)n0 * D + k0, D, scr, lane); return; }
    it -= 22016;
    if (it < 11008) { const int sl = (it >= 5504) ? 1 : 0, r = it - sl * 5504, kb = r >> 6, nb = r & 63, n0 = nb * 32, k0 = kb * 64; const size_t mi = (size_t)(2 * L + sl);
        tr_item(W.w2 + mi * FF * D + (size_t)k0 * D + n0, D, 64, (bf16*)(ws + WS_W2T) + mi * D * FF + (size_t)n0 * FF + k0, FF, scr, lane); return; }
    it -= 11008;
    const int nin = (L & 1) ? 6144 : 8704;
    if (it < nin) {
        if (L & 1) { const int kb = it / 192, nb = it - kb * 192, n0 = nb * 32, k0 = kb * 64;
            tr_item(W.odin + (size_t)li * D * ODC + (size_t)k0 * ODC + n0, ODC, 64, (bf16*)(ws + WS_ODIN) + (size_t)li * ODC * D + (size_t)n0 * D + k0, D, scr, lane); }
        else { const int kb = it / 272, nb = it - kb * 272, n0 = nb * 32, k0 = kb * 64;
            tr_item(n0 < EVC ? W.evin + (size_t)li * D * EVC + (size_t)k0 * EVC + n0 : nullptr, EVC, 64, (bf16*)(ws + WS_EVIN) + (size_t)li * EVP * D + (size_t)n0 * D + k0, D, scr, lane); }
        return; }
    it -= nin;
    if (it < 2048) { const int kb = it >> 6, nb = it & 63, n0 = nb * 32, k0 = kb * 64;
        tr_item(((L & 1) ? W.odout : W.evout) + (size_t)li * D * D + (size_t)k0 * D + n0, D, 64, (bf16*)(ws + ((L & 1) ? WS_ODOUT : WS_EVOUT)) + (size_t)li * D * D + (size_t)n0 * D + k0, D, scr, lane); return; }
    it -= 2048;
    { const int kb = it / 160, nb = it - kb * 160, n0 = nb * 32, seg = n0 >> 10, nloc = n0 & 1023;
      const float* w2 = W.rw2 + (size_t)li * 2 * 64 * 1024; const float* a2 = W.ra2 + (size_t)li * 2 * 64 * 1024; const float* g2 = W.rg2 + (size_t)li * 160 * 1024;
      const float* sp = nullptr; int kvalid = 64;
      if (seg == 0 && kb == 0) sp = w2 + nloc;
      else if (seg == 1 && kb == 2) sp = w2 + 64 * 1024 + nloc;
      else if (seg == 2 && kb == 4) sp = a2 + nloc;
      else if (seg == 3 && kb == 6) sp = a2 + 64 * 1024 + nloc;
      else if (seg == 4 && kb >= 8 && kb <= 10) { sp = g2 + (size_t)(kb - 8) * 64 * 1024 + nloc; kvalid = (kb == 10) ? 32 : 64; }
      tr_item(sp, 1024, kvalid, (bf16*)(ws + WS_LRW) + (size_t)li * 5120 * LK + (size_t)n0 * LK + kb * 64, LK, scr, lane); }
}
DEVI int list_items(int l) { return l < 0 ? 11008 : layer_items(l) - 11008 + (l < 3 ? 11008 : 0); }
DEVI int list_w1b_end(int l) { return 5504 + (layer_items(l) - 33024) + 11008; }
DEVI void convert_tail(const WSrc& W, KGAS unsigned char* ws, int l, unsigned* ctr, int maxgrabs, int stop_at, LAS unsigned char* lds, int tid, int wave, int lane) {
    volatile LAS unsigned* slot = (volatile LAS unsigned*)(lds + 98304 + 64);
    LAS float* scr = (LAS float*)(lds + wave * 8704);
    const int NI = list_items(l);
    for (int g = 0; g < maxgrabs; ++g) {
        if (tid == 0) { unsigned b_ = 0xffffffffu;
            if (stop_at >= (1 << 30) || __hip_atomic_load(ctr, __ATOMIC_RELAXED, __HIP_MEMORY_SCOPE_AGENT) < (unsigned)stop_at) b_ = __hip_atomic_fetch_add(ctr, 8u, __ATOMIC_RELAXED, __HIP_MEMORY_SCOPE_AGENT);
            *slot = b_; }
        __syncthreads();
        const unsigned base = *slot;
        __syncthreads();
        if (base >= (unsigned)NI) break;
        const int idx = (int)base + wave;
        if (idx < NI) { int L = l < 0 ? 0 : l, it = idx;
            if (l >= 0) { const int nmix = layer_items(l) - 33024;
                if (idx < 5504) it = 22016 + idx;
                else if (idx < 5504 + nmix) it = 33024 + (idx - 5504);
                else if (idx < 5504 + nmix + 11008) it = 11008 + (idx - 5504 - nmix);
                else if (idx < 5504 + nmix + 16512) it = 27520 + (idx - 5504 - nmix - 11008);
                else { L = l + 1; it = idx - (5504 + nmix + 16512); } }
            convert_layer_item(W, ws, L, it, scr, lane); }
    }
}

DEVI void ada_cond(const float* c_ctx, const float* c, LAS float* sc, int tid) {
    for (int i = tid; i < 3 * D; i += NTHR) { const int g = i / D, k = i - g * D; const float x = (g == 0) ? c_ctx[k] : c[(g - 1) * D + k]; sc[i] = siluf_(x); }
    __syncthreads();
}
DEVI void ada_item(const float* ada_w, const float* ada_b, float* MOD, int l, int n0, const LAS float* sc, LAS float* red, int tid) {
    const int c4 = tid % 18, ks = tid / 18;
    if (ks < 28) {
        const float* W = ada_w + (size_t)l * D * NMOD + n0 + 4 * c4;
        f32x4 a0 = {0.f, 0.f, 0.f, 0.f}, a1 = a0, a2 = a0;
#pragma unroll 8
        for (int k = ks; k < D; k += 28) { const f32x4 w = *(const f32x4*)(W + (size_t)k * NMOD); a0 += w * sc[k]; a1 += w * sc[D + k]; a2 += w * sc[2 * D + k]; }
        LAS float* r = red + ks * 216 + 4 * c4;
        *(LAS f32x4*)(r) = a0; *(LAS f32x4*)(r + 72) = a1; *(LAS f32x4*)(r + 144) = a2;
    }
    __syncthreads();
    if (tid < 216) { float s_ = 0.f;
#pragma unroll
        for (int j = 0; j < 28; ++j) s_ += red[j * 216 + tid];
        const int g = tid / 72, n = n0 + (tid - g * 72);
        MOD[((size_t)l * 3 + g) * NMOD + n] = s_ + ada_b[(size_t)l * NMOD + n]; }
    __syncthreads();
}

DEVI f32x4 bf4_to_f32(v2u a) { f32x4 r; r.x = __uint_as_float(a.x << 16); r.y = __uint_as_float(a.x & 0xffff0000u); r.z = __uint_as_float(a.y << 16); r.w = __uint_as_float(a.y & 0xffff0000u); return r; }
template <bool HAS_Y, bool HAS_H, bool XIN_B, bool XOUT_B>
DEVI void row_phase(const void* xa, const void* xb, const bf16* Y, void* xout, bf16* H, float fac,
                    const float* modv  , int gate_idx, const float* nw_post,
                    const float* modn  , int sh_idx, const float* nw_pre, LAS unsigned char* lds, int tid, int gw, int lane) {
    LAS float* pv = (LAS float*)lds;
#pragma unroll
    for (int g = 0; g < 3; ++g) { const int col = 4 * tid;
        if (HAS_Y) { const f32x4 gt = *(const f32x4*)(modv + (size_t)g * NMOD + gate_idx * D + col); const f32x4 nw = *(const f32x4*)(nw_post + col); *(LAS f32x4*)(pv + (g * 3 + 0) * D + col) = gt * nw * fac; }
        if (HAS_H) { const f32x4 sh = *(const f32x4*)(modn + (size_t)g * NMOD + sh_idx * D + col); const f32x4 scl = *(const f32x4*)(modn + (size_t)g * NMOD + (sh_idx + 1) * D + col); const f32x4 nw = *(const f32x4*)(nw_pre + col);
            *(LAS f32x4*)(pv + (g * 3 + 1) * D + col) = nw * (scl + 1.0f); *(LAS f32x4*)(pv + (g * 3 + 2) * D + col) = sh; } }
    __syncthreads();
    f32x4 nx[8]; v2u nxb[8], ny0[8], ny1[8];
#define RP_LOADX(m_) do { const size_t ro_ = ((m_) < MP) ? (size_t)(m_) * D : (size_t)((m_) - MP) * D; const void* base_ = ((m_) < MP) ? xa : xb; \
      _Pragma("unroll") for (int j = 0; j < 8; ++j) { if (XIN_B) nxb[j] = *(const v2u*)((const bf16*)base_ + ro_ + 4 * lane + 256 * j); else nx[j] = *(const f32x4*)((const float*)base_ + ro_ + 4 * lane + 256 * j); \
        if (HAS_Y) { ny0[j] = *(const v2u*)(Y + (size_t)(m_) * D + 4 * lane + 256 * j); ny1[j] = *(const v2u*)(Y + (size_t)(M + (m_)) * D + 4 * lane + 256 * j); } } } while (0)
    RP_LOADX(gw);
#pragma nounroll
    for (int i = 0; i < 6; ++i) {
        const int m = gw + 2048 * i;
        const int g = (i < 4) ? 0 : (i - 3);
        const LAS float* pg = pv + g * 3 * D + 4 * lane;
        f32x4 x[8], y[8];
#pragma unroll
        for (int j = 0; j < 8; ++j) { x[j] = XIN_B ? bf4_to_f32(nxb[j]) : nx[j]; if (HAS_Y) y[j] = bf4_to_f32(ny0[j]) + bf4_to_f32(ny1[j]); }
        if (i + 1 < 6) RP_LOADX(m + 2048);
        if (HAS_Y) {
            float ss = 0.f;
#pragma unroll
            for (int j = 0; j < 8; ++j) ss += (y[j].x * y[j].x + y[j].y * y[j].y) + (y[j].z * y[j].z + y[j].w * y[j].w);
            const float rs = rsqrtf(wave_sum(ss) * (1.0f / D) + NORM_EPS);
#pragma unroll
            for (int j = 0; j < 8; ++j) x[j] += *(const LAS f32x4*)(pg + 256 * j) * y[j] * rs;
        }
#pragma unroll
        for (int j = 0; j < 8; ++j) {
            if (XOUT_B) { v2u o; o.x = pk2(x[j].x, x[j].y); o.y = pk2(x[j].z, x[j].w); *(v2u*)((bf16*)xout + (size_t)m * D + 4 * lane + 256 * j) = o; }
            else *(f32x4*)((float*)xout + (size_t)m * D + 4 * lane + 256 * j) = x[j]; }
        if (HAS_H) {
            float ss = 0.f;
#pragma unroll
            for (int j = 0; j < 8; ++j) ss += (x[j].x * x[j].x + x[j].y * x[j].y) + (x[j].z * x[j].z + x[j].w * x[j].w);
            const float rs = rsqrtf(wave_sum(ss) * (1.0f / D) + NORM_EPS);
#pragma unroll
            for (int j = 0; j < 8; ++j) { const int col = 4 * lane + 256 * j;
                const f32x4 hv = x[j] * rs * *(const LAS f32x4*)(pg + D + 256 * j) + *(const LAS f32x4*)(pg + 2 * D + 256 * j); v2u o; o.x = pk2(hv.x, hv.y); o.y = pk2(hv.z, hv.w);
                *(v2u*)(H + (size_t)m * D + col) = o; }
        }
    }
#undef RP_LOADX
}

DEVI float bf1(bf16 v) { return __uint_as_float((unsigned)v << 16); }
DEVI float shifted(const bf16* U, int m, int col, float mu, int t, int T) {
    const float x = bf1(U[(size_t)m * EVP + col]);
    const float p = (t > 0) ? bf1(U[(size_t)(m - 1) * EVP + col]) : 0.f;
    const float n = (t < T - 1) ? bf1(U[(size_t)(m + 1) * EVP + col]) : 0.f;
    return x + mu * (0.5f * (p + n) - x);
}
DEVI f32x4 sigmoid4(f32x4 x) { f32x4 r; r.x = sigmoidf_(x.x); r.y = sigmoidf_(x.y); r.z = sigmoidf_(x.z); r.w = sigmoidf_(x.w); return r; }
DEVI void e1a_phase(const bf16* U, const float* mu, bf16* L, int gtid, int nthreads) {
    for (int idx = gtid; idx < M * (LK / 8); idx += nthreads) {
        const int m = idx / (LK / 8), k = (idx - m * (LK / 8)) * 8; int t, T; seq_pos(m, t, T);
        int col = -1, mode = 0;
        if (k < 512) { const int sec = k >> 7, o = k & 127; if (o < 64) { if (sec < 2) { col = 3232 + sec * 64 + o; } else { col = 3360 + (sec - 2) * 64 + o; mode = 1; } } }
        else if (k < 672) { col = 3072 + (k - 512); mode = 2; }
        v4u o4 = {0u, 0u, 0u, 0u};
        if (col >= 0) {
            const bf16* ub = U + (size_t)m * EVP + col;
            const v4u x4 = *(const v4u*)ub; v4u p4 = {0u, 0u, 0u, 0u}, n4 = p4;
            if (t > 0) p4 = *(const v4u*)(ub - EVP);
            if (t < T - 1) n4 = *(const v4u*)(ub + EVP);
            const f32x4 m0 = *(const f32x4*)(mu + col), m1 = *(const f32x4*)(mu + col + 4);
            f32x4 r0, r1;
            { const f32x4 x = bf4_to_f32((v2u){x4.x, x4.y}), p = bf4_to_f32((v2u){p4.x, p4.y}), n = bf4_to_f32((v2u){n4.x, n4.y}); r0 = x + m0 * ((p + n) * 0.5f - x); }
            { const f32x4 x = bf4_to_f32((v2u){x4.z, x4.w}), p = bf4_to_f32((v2u){p4.z, p4.w}), n = bf4_to_f32((v2u){n4.z, n4.w}); r1 = x + m1 * ((p + n) * 0.5f - x); }
            if (mode == 0) { r0.x = tanhf(r0.x); r0.y = tanhf(r0.y); r0.z = tanhf(r0.z); r0.w = tanhf(r0.w); r1.x = tanhf(r1.x); r1.y = tanhf(r1.y); r1.z = tanhf(r1.z); r1.w = tanhf(r1.w); }
            else if (mode == 2) { r0 = sigmoid4(r0); r1 = sigmoid4(r1); }
            o4.x = pk2(r0.x, r0.y); o4.y = pk2(r0.z, r0.w); o4.z = pk2(r1.x, r1.y); o4.w = pk2(r1.z, r1.w);
        }
        *(v4u*)(L + (size_t)m * LK + k) = o4;
    }
}
struct EvenPtrs {
    const bf16* U; const bf16* LR;
    float *RWV, *BONUS, *RWO, *HGO;
    const float *mu, *w0, *a0, *kk_w, *ka_w, *r_k, *ln_w, *ln_b, *lb0, *lb1, *hg_nw;
    int li;
};
DEVI f32x4 exp4(f32x4 x) { f32x4 r; r.x = __expf(x.x); r.y = __expf(x.y); r.z = __expf(x.z); r.w = __expf(x.w); return r; }
DEVI float hsum4(f32x4 x) { return (x.x + x.y) + (x.z + x.w); }
constexpr int SCH = 32;
DEVI void scan_rwkv_unit(const EvenPtrs& P, const float* st_in, float* st_out, int idx, LAS float* buf, int tid, int slab, int lane) {
    const bool sample = idx < 64; const int u = sample ? idx : idx - 64;
    const int h = u & 15, dir = (u >> 4) & 1, b = u >> 5, row0 = sample ? MP + b * 2048 : b * 256, T = sample ? 2048 : 256, nch = T / SCH;
    const size_t doff = (size_t)dir * M * 1024, soff = ((((size_t)b * 2 + P.li) * 2 + dir) * 16 + h) * 4096;
    float* Og = P.RWO + doff + h * 64; LAS float* obuf = buf + 2 * SCH * 384 + 64;
    const int r8 = lane >> 3, kg = lane & 7, vrow = slab * 8 + r8;
    f32x2 S[4];
    if (sample) {
#pragma unroll
        for (int j = 0; j < 4; ++j) S[j] = *(const f32x2*)(st_in + soff + vrow * 64 + kg * 8 + 2 * j);
    } else {
#pragma unroll
        for (int j = 0; j < 4; ++j) S[j] = (f32x2){0.f, 0.f};
    }
    const int lst = tid >> 4, lp = tid & 15, c = h * 64 + lp * 4;
    v2u ur[3], uk[3], uv[3]; f32x4 lw, la;
#define SC_LOAD(cn) do { const int s_ = (cn) * SCH + lst; const int t_ = dir ? (T - 1 - s_) : s_; const int m_ = row0 + t_; const bf16* ub_ = P.U + (size_t)m_ * EVP + c; \
        ur[1] = *(const v2u*)ub_; uk[1] = *(const v2u*)(ub_ + 1024); uv[1] = *(const v2u*)(ub_ + 2048); \
        const v2u z_ = {0u, 0u}; ur[0] = z_; uk[0] = z_; uv[0] = z_; ur[2] = z_; uk[2] = z_; uv[2] = z_; \
        if (t_ > 0) { ur[0] = *(const v2u*)(ub_ - EVP); uk[0] = *(const v2u*)(ub_ - EVP + 1024); uv[0] = *(const v2u*)(ub_ - EVP + 2048); } \
        if (t_ < T - 1) { ur[2] = *(const v2u*)(ub_ + EVP); uk[2] = *(const v2u*)(ub_ + EVP + 1024); uv[2] = *(const v2u*)(ub_ + EVP + 2048); } \
        const bf16* lr_ = P.LR + (size_t)m_ * 5120 + dir * 1024 + c; lw = bf4_to_f32(*(const v2u*)lr_); la = bf4_to_f32(*(const v2u*)(lr_ + 2048)); } while (0)
#define SC_STORE(bs, cn) do { const int s_ = (cn) * SCH + lst; const int t_ = dir ? (T - 1 - s_) : s_; const int m_ = row0 + t_; \
        const f32x4 mu_r = *(const f32x4*)(P.mu + c), mu_k = *(const f32x4*)(P.mu + 1024 + c), mu_v = *(const f32x4*)(P.mu + 2048 + c); \
        const f32x4 kkw = *(const f32x4*)(P.kk_w + c), kaw = *(const f32x4*)(P.ka_w + c), rk = *(const f32x4*)(P.r_k + c); \
        const f32x4 w0d = *(const f32x4*)(P.w0 + dir * 1024 + c), a0d = *(const f32x4*)(P.a0 + dir * 1024 + c); \
        const f32x4 r1_ = bf4_to_f32(ur[1]), k1_ = bf4_to_f32(uk[1]), v1_ = bf4_to_f32(uv[1]); \
        const f32x4 r_ = r1_ + mu_r * ((bf4_to_f32(ur[0]) + bf4_to_f32(ur[2])) * 0.5f - r1_), k_ = k1_ + mu_k * ((bf4_to_f32(uk[0]) + bf4_to_f32(uk[2])) * 0.5f - k1_), v_ = v1_ + mu_v * ((bf4_to_f32(uv[0]) + bf4_to_f32(uv[2])) * 0.5f - v1_); \
        const f32x4 kkv_ = k_ * kkw; const float nrm_ = sqrtf(sum16(hsum4(kkv_ * kkv_))); const f32x4 kk_ = kkv_ * (1.0f / fmaxf(nrm_, 1e-12f)); \
        const f32x4 dec_ = exp4(sigmoid4(w0d + lw) * (-0.6065306597126334f)); const f32x4 a_ = sigmoid4(a0d + la); const f32x4 kd_ = k_ * ((a_ - 1.0f) * kaw + 1.0f); \
        const float bon_ = sum16(hsum4(r_ * kd_ * rk)); if (lp == 0) P.BONUS[((size_t)dir * M + m_) * 16 + h] = bon_; \
        if (dir == 0) *(f32x4*)(P.RWV + (size_t)m_ * 1024 + c) = v_; \
        LAS float* d_ = buf + (bs) * (SCH * 384) + lst * 384 + lp * 4; \
        *(LAS f32x4*)(d_) = r_; *(LAS f32x4*)(d_ + 64) = kk_; *(LAS f32x4*)(d_ + 128) = v_; *(LAS f32x4*)(d_ + 192) = dec_; *(LAS f32x4*)(d_ + 256) = kd_; *(LAS f32x4*)(d_ + 320) = kk_ * a_; } while (0)
    SC_LOAD(0); SC_STORE(0, 0);
    __syncthreads();
    for (int c_ = 0; c_ < nch; ++c_) {
        if (c_ + 1 < nch) SC_LOAD(c_ + 1);
        const LAS float* cb = buf + (c_ & 1) * (SCH * 384);
        const LAS float* sp0 = cb + kg * 8;
        f32x4 nr0 = *(const LAS f32x4*)(sp0), nr1 = *(const LAS f32x4*)(sp0 + 4), nk0 = *(const LAS f32x4*)(sp0 + 64), nk1 = *(const LAS f32x4*)(sp0 + 68),
              nw0 = *(const LAS f32x4*)(sp0 + 192), nw1 = *(const LAS f32x4*)(sp0 + 196), nd0 = *(const LAS f32x4*)(sp0 + 256), nd1 = *(const LAS f32x4*)(sp0 + 260),
              nb0 = *(const LAS f32x4*)(sp0 + 320), nb1 = *(const LAS f32x4*)(sp0 + 324);
        float nvv = cb[128 + vrow];
        LAS float* ob = obuf + (c_ & 1) * (SCH * 64);
#pragma unroll 8
        for (int st = 0; st < SCH; ++st) {
            const f32x4 r0 = nr0, r1 = nr1, k0 = nk0, k1 = nk1, w0 = nw0, w1 = nw1, d0 = nd0, d1 = nd1, b0 = nb0, b1 = nb1; const float vv = nvv;
            { const LAS float* sp = cb + ((st + 1) & (SCH - 1)) * 384 + kg * 8;
              nr0 = *(const LAS f32x4*)(sp); nr1 = *(const LAS f32x4*)(sp + 4); nk0 = *(const LAS f32x4*)(sp + 64); nk1 = *(const LAS f32x4*)(sp + 68);
              nw0 = *(const LAS f32x4*)(sp + 192); nw1 = *(const LAS f32x4*)(sp + 196); nd0 = *(const LAS f32x4*)(sp + 256); nd1 = *(const LAS f32x4*)(sp + 260);
              nb0 = *(const LAS f32x4*)(sp + 320); nb1 = *(const LAS f32x4*)(sp + 324); nvv = cb[((st + 1) & (SCH - 1)) * 384 + 128 + vrow]; }
            const f32x2 kk2[4] = {{k0.x, k0.y}, {k0.z, k0.w}, {k1.x, k1.y}, {k1.z, k1.w}};
            const f32x2 w2[4] = {{w0.x, w0.y}, {w0.z, w0.w}, {w1.x, w1.y}, {w1.z, w1.w}};
            const f32x2 kd2[4] = {{d0.x, d0.y}, {d0.z, d0.w}, {d1.x, d1.y}, {d1.z, d1.w}};
            const f32x2 b2[4] = {{b0.x, b0.y}, {b0.z, b0.w}, {b1.x, b1.y}, {b1.z, b1.w}};
            const f32x2 r2[4] = {{r0.x, r0.y}, {r0.z, r0.w}, {r1.x, r1.y}, {r1.z, r1.w}};
            f32x2 sa2 = S[0] * kk2[0];
#pragma unroll
            for (int j = 1; j < 4; ++j) sa2 += S[j] * kk2[j];
            const float sa = -sum8(sa2.x + sa2.y);
            const f32x2 sav = {sa, sa}, vv2 = {vv, vv};
            f32x2 o2 = {0.f, 0.f};
#pragma unroll
            for (int j = 0; j < 4; ++j) { S[j] = S[j] * w2[j] + (sav * b2[j] + vv2 * kd2[j]); o2 += S[j] * r2[j]; }
            const float o = sum8(o2.x + o2.y);
            ob[st * 64 + vrow] = o;
        }
        if (c_ + 1 < nch) SC_STORE((c_ + 1) & 1, c_ + 1);
        __syncthreads();
        { const int s_ = c_ * SCH + lst; const int t_ = dir ? (T - 1 - s_) : s_;
          *(f32x4*)(Og + (size_t)(row0 + t_) * 1024 + lp * 4) = *(const LAS f32x4*)(ob + lst * 64 + lp * 4); }
    }
#undef SC_LOAD
#undef SC_STORE
    if (!sample) {
#pragma unroll
        for (int j = 0; j < 4; ++j) *(f32x2*)(st_out + soff + vrow * 64 + kg * 8 + 2 * j) = S[j];
    }
}
DEVI void scan_hgrn_unit(const EvenPtrs& P, const float* st_in, float* st_out, int idx, LAS float* buf, int tid, int slab, int lane) {
    const bool sample = idx < 64; const int u = sample ? idx : idx - 64;
    const int h = u & 15, dir = (u >> 4) & 1, b = u >> 5, row0 = sample ? MP + b * 2048 : b * 256, T = sample ? 2048 : 256, nch = T / SCH;
    const size_t doff = (size_t)dir * M * 1024, soff = ((((size_t)b * 2 + P.li) * 2 + dir) * 16 + h) * 4096;
    const int r8 = lane >> 3, kg = lane & 7, vcol = slab * 8 + r8;
    float* Og = P.HGO + doff + h * 64; LAS float* obuf = buf + 2 * SCH * 384 + 64;
    f32x2 S[4];
    if (sample) {
#pragma unroll
        for (int j = 0; j < 4; ++j) { S[j].x = st_in[soff + (kg * 8 + 2 * j) * 64 + vcol]; S[j].y = st_in[soff + (kg * 8 + 2 * j + 1) * 64 + vcol]; }
    } else {
#pragma unroll
        for (int j = 0; j < 4; ++j) S[j] = (f32x2){0.f, 0.f};
    }
    const int lst = tid >> 4, lp = tid & 15, c = h * 64 + lp * 4;
    f32x4 lb = {0.f, 0.f, 0.f, 0.f};
    if (P.li != 0) lb = sigmoid4(*(const f32x4*)(P.lb1 + dir * 1024 + c) - *(const f32x4*)(P.lb0 + dir * 1024 + c));
    f32x4 uq, uf, ui;
#define SH_LOAD(cn) do { const int s_ = (cn) * SCH + lst; const int t_ = dir ? (T - 1 - s_) : s_; const bf16* ub_ = P.U + (size_t)(row0 + t_) * EVP + ACOLS + c; \
        uq = bf4_to_f32(*(const v2u*)ub_); ui = bf4_to_f32(*(const v2u*)(ub_ + 1024)); uf = bf4_to_f32(*(const v2u*)(ub_ + 3072 + dir * 1024)); } while (0)
#define SH_STORE(bs) do { LAS float* d_ = buf + (bs) * (SCH * 192) + lst * 192 + lp * 4; \
        *(LAS f32x4*)(d_) = uq * sigmoid4(uq); *(LAS f32x4*)(d_ + 64) = lb + (1.0f - lb) * sigmoid4(uf); *(LAS f32x4*)(d_ + 128) = ui; } while (0)
    SH_LOAD(0); SH_STORE(0);
    __syncthreads();
    for (int c_ = 0; c_ < nch; ++c_) {
        if (c_ + 1 < nch) SH_LOAD(c_ + 1);
        const LAS float* cb = buf + (c_ & 1) * (SCH * 192);
        const LAS float* sp0 = cb + kg * 8;
        f32x4 nq0 = *(const LAS f32x4*)(sp0), nq1 = *(const LAS f32x4*)(sp0 + 4), nf0 = *(const LAS f32x4*)(sp0 + 64), nf1 = *(const LAS f32x4*)(sp0 + 68);
        float nvv = cb[128 + vcol];
        LAS float* ob = obuf + (c_ & 1) * (SCH * 64);
#pragma unroll 8
        for (int st = 0; st < SCH; ++st) {
            const f32x4 q0 = nq0, q1 = nq1, f0 = nf0, f1 = nf1; const float vv = nvv;
            { const LAS float* sp = cb + ((st + 1) & (SCH - 1)) * 192 + kg * 8;
              nq0 = *(const LAS f32x4*)(sp); nq1 = *(const LAS f32x4*)(sp + 4); nf0 = *(const LAS f32x4*)(sp + 64); nf1 = *(const LAS f32x4*)(sp + 68); nvv = cb[((st + 1) & (SCH - 1)) * 192 + 128 + vcol]; }
            const f32x2 q2[4] = {{q0.x, q0.y}, {q0.z, q0.w}, {q1.x, q1.y}, {q1.z, q1.w}};
            const f32x2 f2[4] = {{f0.x, f0.y}, {f0.z, f0.w}, {f1.x, f1.y}, {f1.z, f1.w}};
            const f32x2 vv2 = {vv, vv};
            f32x2 o2 = {0.f, 0.f};
#pragma unroll
            for (int j = 0; j < 4; ++j) { S[j] = vv2 + f2[j] * (S[j] - vv2); o2 += S[j] * q2[j]; }
            const float o = sum8(o2.x + o2.y);
            ob[st * 64 + vcol] = o;
        }
        if (c_ + 1 < nch) SH_STORE((c_ + 1) & 1);
        __syncthreads();
        { const int s_ = c_ * SCH + lst; const int t_ = dir ? (T - 1 - s_) : s_;
          *(f32x4*)(Og + (size_t)(row0 + t_) * 1024 + lp * 4) = *(const LAS f32x4*)(ob + lst * 64 + lp * 4); }
    }
#undef SH_LOAD
#undef SH_STORE
    if (!sample) {
#pragma unroll
        for (int j = 0; j < 4; ++j) { st_out[soff + (kg * 8 + 2 * j) * 64 + vcol] = S[j].x; st_out[soff + (kg * 8 + 2 * j + 1) * 64 + vcol] = S[j].y; }
    }
}
constexpr int WCH = 4;
DEVI void scan_rwkv_wave(const EvenPtrs& P, float* st_out, int u, LAS float* wbuf, int lane) {
    const int h = u & 15, dir = (u >> 4) & 1, b = u >> 5, row0 = b * 256; constexpr int T = 256, nch = T / WCH;
    const size_t doff = (size_t)dir * M * 1024, soff = ((((size_t)b * 2 + P.li) * 2 + dir) * 16 + h) * 4096;
    const int rg = lane >> 3, kg = lane & 7;
    float* O = P.RWO + doff + h * 64 + rg;
    f32x2 S[8][4];
#pragma unroll
    for (int j = 0; j < 8; ++j)
#pragma unroll
        for (int q = 0; q < 4; ++q) S[j][q] = (f32x2){0.f, 0.f};
    const int lst = lane >> 4, lp = lane & 15, c = h * 64 + lp * 4;
    v2u ur[3], uk[3], uv[3]; f32x4 lw, la;
    const int vp0 = ((4 * lp) & 7) * 8 + ((4 * lp) >> 3);
#define WL_LOAD(cn) do { const int s_ = (cn) * WCH + lst; const int t_ = dir ? (T - 1 - s_) : s_; const int m_ = row0 + t_; const bf16* ub_ = P.U + (size_t)m_ * EVP + c; \
        ur[1] = *(const v2u*)ub_; uk[1] = *(const v2u*)(ub_ + 1024); uv[1] = *(const v2u*)(ub_ + 2048); \
        const v2u z_ = {0u, 0u}; ur[0] = z_; uk[0] = z_; uv[0] = z_; ur[2] = z_; uk[2] = z_; uv[2] = z_; \
        if (t_ > 0) { ur[0] = *(const v2u*)(ub_ - EVP); uk[0] = *(const v2u*)(ub_ - EVP + 1024); uv[0] = *(const v2u*)(ub_ - EVP + 2048); } \
        if (t_ < T - 1) { ur[2] = *(const v2u*)(ub_ + EVP); uk[2] = *(const v2u*)(ub_ + EVP + 1024); uv[2] = *(const v2u*)(ub_ + EVP + 2048); } \
        const bf16* lr_ = P.LR + (size_t)m_ * 5120 + dir * 1024 + c; lw = bf4_to_f32(*(const v2u*)lr_); la = bf4_to_f32(*(const v2u*)(lr_ + 2048)); } while (0)
#define WL_STORE(bs, cn) do { const int s_ = (cn) * WCH + lst; const int t_ = dir ? (T - 1 - s_) : s_; const int m_ = row0 + t_; \
        const f32x4 mu_r = *(const f32x4*)(P.mu + c), mu_k = *(const f32x4*)(P.mu + 1024 + c), mu_v = *(const f32x4*)(P.mu + 2048 + c);     \
        const f32x4 kkw = *(const f32x4*)(P.kk_w + c), kaw = *(const f32x4*)(P.ka_w + c), rk = *(const f32x4*)(P.r_k + c); \
        const f32x4 w0d = *(const f32x4*)(P.w0 + dir * 1024 + c), a0d = *(const f32x4*)(P.a0 + dir * 1024 + c); \
        const f32x4 r1_ = bf4_to_f32(ur[1]), k1_ = bf4_to_f32(uk[1]), v1_ = bf4_to_f32(uv[1]); \
        const f32x4 r_ = r1_ + mu_r * ((bf4_to_f32(ur[0]) + bf4_to_f32(ur[2])) * 0.5f - r1_), k_ = k1_ + mu_k * ((bf4_to_f32(uk[0]) + bf4_to_f32(uk[2])) * 0.5f - k1_), v_ = v1_ + mu_v * ((bf4_to_f32(uv[0]) + bf4_to_f32(uv[2])) * 0.5f - v1_); \
        const f32x4 kkv_ = k_ * kkw; const float nrm_ = sqrtf(sum16(hsum4(kkv_ * kkv_))); const f32x4 kk_ = kkv_ * (1.0f / fmaxf(nrm_, 1e-12f)); \
        const f32x4 dec_ = exp4(sigmoid4(w0d + lw) * (-0.6065306597126334f)); const f32x4 a_ = sigmoid4(a0d + la); const f32x4 kd_ = k_ * ((a_ - 1.0f) * kaw + 1.0f); \
        const float bon_ = sum16(hsum4(r_ * kd_ * rk)); if (lp == 0) P.BONUS[((size_t)dir * M + m_) * 16 + h] = bon_; \
        if (dir == 0) *(f32x4*)(P.RWV + (size_t)m_ * 1024 + c) = v_; \
        LAS float* d_ = wbuf + (bs) * (WCH * 384) + lst * 384; \
        *(LAS f32x4*)(d_ + lp * 4) = r_; *(LAS f32x4*)(d_ + 64 + lp * 4) = kk_; *(LAS f32x4*)(d_ + 192 + lp * 4) = dec_; *(LAS f32x4*)(d_ + 256 + lp * 4) = kd_; *(LAS f32x4*)(d_ + 320 + lp * 4) = kk_ * a_; \
        d_[128 + vp0] = v_.x; d_[128 + vp0 + 8] = v_.y; d_[128 + vp0 + 16] = v_.z; d_[128 + vp0 + 24] = v_.w; } while (0)
    WL_LOAD(0); WL_STORE(0, 0);
#pragma nounroll
    for (int c_ = 0; c_ < nch; ++c_) {
        if (c_ + 1 < nch) WL_LOAD(c_ + 1);
        const LAS float* cb = wbuf + (c_ & 1) * (WCH * 384);
#pragma unroll
        for (int st = 0; st < WCH; ++st) {
            const LAS float* sp = cb + st * 384 + kg * 8;
            const f32x4 r0 = *(const LAS f32x4*)(sp), r1 = *(const LAS f32x4*)(sp + 4), k0 = *(const LAS f32x4*)(sp + 64), k1 = *(const LAS f32x4*)(sp + 68);
            const f32x4 w0 = *(const LAS f32x4*)(sp + 192), w1 = *(const LAS f32x4*)(sp + 196), d0 = *(const LAS f32x4*)(sp + 256), d1 = *(const LAS f32x4*)(sp + 260);
            const f32x4 b0 = *(const LAS f32x4*)(sp + 320), b1 = *(const LAS f32x4*)(sp + 324);
            const f32x4 va = *(const LAS f32x4*)(cb + st * 384 + 128 + rg * 8), vb = *(const LAS f32x4*)(cb + st * 384 + 132 + rg * 8);
            const float vvs[8] = {va.x, va.y, va.z, va.w, vb.x, vb.y, vb.z, vb.w};
            const f32x2 kk2[4] = {{k0.x, k0.y}, {k0.z, k0.w}, {k1.x, k1.y}, {k1.z, k1.w}};
            const f32x2 w2[4] = {{w0.x, w0.y}, {w0.z, w0.w}, {w1.x, w1.y}, {w1.z, w1.w}};
            const f32x2 kd2[4] = {{d0.x, d0.y}, {d0.z, d0.w}, {d1.x, d1.y}, {d1.z, d1.w}};
            const f32x2 b2[4] = {{b0.x, b0.y}, {b0.z, b0.w}, {b1.x, b1.y}, {b1.z, b1.w}};
            const f32x2 r2[4] = {{r0.x, r0.y}, {r0.z, r0.w}, {r1.x, r1.y}, {r1.z, r1.w}};
            const int s_ = c_ * WCH + st; const int t_ = dir ? (T - 1 - s_) : s_;
            float* Ot = O + (size_t)(row0 + t_) * 1024;
#pragma unroll
            for (int j = 0; j < 8; ++j) {
                f32x2 sa2 = S[j][0] * kk2[0];
#pragma unroll
                for (int q = 1; q < 4; ++q) sa2 += S[j][q] * kk2[q];
                const float sa = -sum8(sa2.x + sa2.y);
                const f32x2 sav = {sa, sa}, vv2 = {vvs[j], vvs[j]};
                f32x2 o2 = {0.f, 0.f};
#pragma unroll
                for (int q = 0; q < 4; ++q) { S[j][q] = S[j][q] * w2[q] + (sav * b2[q] + vv2 * kd2[q]); o2 += S[j][q] * r2[q]; }
                Ot[8 * j] = sum8(o2.x + o2.y);
            }
        }
        if (c_ + 1 < nch) WL_STORE((c_ + 1) & 1, c_ + 1);
    }
#undef WL_LOAD
#undef WL_STORE
#pragma unroll
    for (int j = 0; j < 8; ++j) { float* so = st_out + soff + (rg + 8 * j) * 64 + kg * 8;
        *(f32x4*)so = (f32x4){S[j][0].x, S[j][0].y, S[j][1].x, S[j][1].y}; *(f32x4*)(so + 4) = (f32x4){S[j][2].x, S[j][2].y, S[j][3].x, S[j][3].y}; }
}
DEVI void scan_hgrn_wave(const EvenPtrs& P, float* st_out, int u, LAS float* wbuf, int lane) {
    const int h = u & 15, dir = (u >> 4) & 1, b = u >> 5, row0 = b * 256; constexpr int T = 256, nch = T / WCH;
    const size_t doff = (size_t)dir * M * 1024, soff = ((((size_t)b * 2 + P.li) * 2 + dir) * 16 + h) * 4096;
    const int cg = lane >> 3, kg = lane & 7;
    float* O = P.HGO + doff + h * 64 + cg;
    f32x2 S[8][4];
#pragma unroll
    for (int j = 0; j < 8; ++j)
#pragma unroll
        for (int q = 0; q < 4; ++q) S[j][q] = (f32x2){0.f, 0.f};
    const int lst = lane >> 4, lp = lane & 15, c = h * 64 + lp * 4;
    const int vp0 = ((4 * lp) & 7) * 8 + ((4 * lp) >> 3);
    f32x4 lb = {0.f, 0.f, 0.f, 0.f};
    if (P.li != 0) lb = sigmoid4(*(const f32x4*)(P.lb1 + dir * 1024 + c) - *(const f32x4*)(P.lb0 + dir * 1024 + c));
    v2u uq, uf, ui;
#define WH_LOAD(cn) do { const int s_ = (cn) * WCH + lst; const int t_ = dir ? (T - 1 - s_) : s_; const bf16* ub_ = P.U + (size_t)(row0 + t_) * EVP + ACOLS + c; \
        uq = *(const v2u*)ub_; ui = *(const v2u*)(ub_ + 1024); uf = *(const v2u*)(ub_ + 3072 + dir * 1024); } while (0)
#define WH_STORE(bs) do { LAS float* d_ = wbuf + (bs) * (WCH * 192) + lst * 192; const f32x4 q_ = bf4_to_f32(uq), i_ = bf4_to_f32(ui); \
        *(LAS f32x4*)(d_ + lp * 4) = q_ * sigmoid4(q_); *(LAS f32x4*)(d_ + 64 + lp * 4) = lb + (1.0f - lb) * sigmoid4(bf4_to_f32(uf)); \
        d_[128 + vp0] = i_.x; d_[128 + vp0 + 8] = i_.y; d_[128 + vp0 + 16] = i_.z; d_[128 + vp0 + 24] = i_.w; } while (0)
    WH_LOAD(0); WH_STORE(0);
#pragma nounroll
    for (int c_ = 0; c_ < nch; ++c_) {
        if (c_ + 1 < nch) WH_LOAD(c_ + 1);
        const LAS float* cb = wbuf + (c_ & 1) * (WCH * 192);
#pragma unroll
        for (int st = 0; st < WCH; ++st) {
            const LAS float* sp = cb + st * 192 + kg * 8;
            const f32x4 q0 = *(const LAS f32x4*)(sp), q1 = *(const LAS f32x4*)(sp + 4), f0 = *(const LAS f32x4*)(sp + 64), f1 = *(const LAS f32x4*)(sp + 68);
            const f32x4 va = *(const LAS f32x4*)(cb + st * 192 + 128 + cg * 8), vb = *(const LAS f32x4*)(cb + st * 192 + 132 + cg * 8);
            const float vvs[8] = {va.x, va.y, va.z, va.w, vb.x, vb.y, vb.z, vb.w};
            const f32x2 q2[4] = {{q0.x, q0.y}, {q0.z, q0.w}, {q1.x, q1.y}, {q1.z, q1.w}};
            const f32x2 f2[4] = {{f0.x, f0.y}, {f0.z, f0.w}, {f1.x, f1.y}, {f1.z, f1.w}};
            const int s_ = c_ * WCH + st; const int t_ = dir ? (T - 1 - s_) : s_;
            float* Ot = O + (size_t)(row0 + t_) * 1024;
#pragma unroll
            for (int j = 0; j < 8; ++j) {
                const f32x2 vv2 = {vvs[j], vvs[j]};
                f32x2 o2 = {0.f, 0.f};
#pragma unroll
                for (int q = 0; q < 4; ++q) { S[j][q] = vv2 + f2[q] * (S[j][q] - vv2); o2 += S[j][q] * q2[q]; }
                Ot[8 * j] = sum8(o2.x + o2.y);
            }
        }
        if (c_ + 1 < nch) WH_STORE((c_ + 1) & 1);
    }
#undef WH_LOAD
#undef WH_STORE
#pragma unroll
    for (int j = 0; j < 8; ++j)
#pragma unroll
        for (int q = 0; q < 4; ++q) { float* so = st_out + soff + (size_t)(kg * 8 + 2 * q) * 64 + cg + 8 * j; so[0] = S[j][q].x; so[64] = S[j][q].y; }
}
DEVI void e2_phase(const EvenPtrs& P, const float* st_rwkv, const float* st_hgrn, float* out_rwkv, float* out_hgrn, unsigned* qctr, LAS unsigned char* lds, int tid, int wave, int lane) {
    LAS float* buf = (LAS float*)lds;
    volatile LAS unsigned* slot = (volatile LAS unsigned*)(lds + 2 * SCH * 384 * 4);
    for (;;) {
        if (tid == 0) *slot = __hip_atomic_fetch_add(qctr, 1u, __ATOMIC_RELAXED, __HIP_MEMORY_SCOPE_AGENT);
        __syncthreads();
        const int task = (int)*slot;
        __syncthreads();
        if (task >= 384 + 256) break;
        if (task >= 384) {
            const float* const* pt_ = (const float* const*)((KGAS unsigned char*)P.RWO - (WS_RWO - WS_PTRS));
            const float* c_ctx = pt_[0]; const float* c_lat = pt_[1]; const float* ada_w = pt_[2]; const float* ada_b = pt_[3];
            const int t2_ = launder_v(tid);
            ada_cond(c_ctx, c_lat, buf, t2_);
            ada_item(ada_w, ada_b, (float*)((KGAS unsigned char*)P.RWO - (WS_RWO - WS_MOD)), 2 * P.li + 1, (task - 384) * 72, buf, buf + 6144, t2_);
            continue; }
        if (task < 64) scan_rwkv_unit(P, st_rwkv, out_rwkv, task, buf, tid, wave, lane);
        else if (task < 128) scan_hgrn_unit(P, st_hgrn, out_hgrn, task - 64, buf, tid, wave, lane);
        else if (task < 256) scan_rwkv_wave(P, out_rwkv, (task - 128) * 8 + wave, buf + wave * (2 * WCH * 384), lane);
        else scan_hgrn_wave(P, out_hgrn, (task - 256) * 8 + wave, buf + wave * (2 * WCH * 384), lane);
    }
}
DEVI void e3_phase(const EvenPtrs& P, bf16* MIXO, int gw, int NGW, int lane) {
    const int hq = gw & 3, c = hq * 256 + 4 * lane;
    const f32x4 lnw = *(const f32x4*)(P.ln_w + c), lnb = *(const f32x4*)(P.ln_b + c), hnw = *(const f32x4*)(P.hg_nw + c);
    for (int it = gw; it < M * 4; it += NGW) {
        const int m = it >> 2;
        const size_t o1 = (size_t)m * 1024 + c;
        f32x4 o = *(const f32x4*)(P.RWO + o1) + *(const f32x4*)(P.RWO + (size_t)M * 1024 + o1);
        f32x4 ob = *(const f32x4*)(P.HGO + o1) + *(const f32x4*)(P.HGO + (size_t)M * 1024 + o1);
        const f32x4 vv = *(const f32x4*)(P.RWV + o1), gg = bf4_to_f32(*(const v2u*)(P.LR + (size_t)m * 5120 + 4096 + c)), ug = bf4_to_f32(*(const v2u*)(P.U + (size_t)m * EVP + ACOLS + 2048 + c));
        const float bonus = P.BONUS[(size_t)m * 16 + hq * 4 + (lane >> 4)] + P.BONUS[((size_t)M + m) * 16 + hq * 4 + (lane >> 4)];
        const float mean = sum16(hsum4(o)) * (1.0f / 64.0f);
        const f32x4 dlt = o - mean;
        const float var = sum16(hsum4(dlt * dlt)) * (1.0f / 64.0f);
        o = dlt * rsqrtf(var + 64e-5f) * lnw + lnb;
        o = (o + vv * bonus) * gg;
        const float ms = sum16(hsum4(ob * ob)) * (1.0f / 64.0f);
        ob = ob * rsqrtf(ms + NORM_EPS) * hnw * (ug * sigmoid4(ug));
        v2u w0, w1; w0.x = pk2(o.x, o.y); w0.y = pk2(o.z, o.w); w1.x = pk2(ob.x, ob.y); w1.y = pk2(ob.z, ob.w);
        *(v2u*)(MIXO + (size_t)m * D + c) = w0; *(v2u*)(MIXO + (size_t)m * D + 1024 + c) = w1;
    }
}

constexpr float QSCALE = 0.125f * LOG2E;
struct OddPtrs {
    const bf16* UB; const bf16 *CNK, *CNV, *CDK, *CDV;
    const float *rpb, *dlam, *dnw;
    int li; float lam_init;
};
DEVI int crow(int reg, int h) { return (reg & 3) + 8 * (reg >> 2) + 4 * h; }
#define MFMA32(a, b, c) __builtin_amdgcn_mfma_f32_32x32x16_bf16((a), (b), (c), 0, 0, 0)
typedef short v4i16_t __attribute__((ext_vector_type(4)));
DEVI s16x4 vtr(const LAS unsigned char* p) { return __builtin_bit_cast(s16x4, __builtin_amdgcn_ds_read_tr16_b64_v4i16((LAS v4i16_t*)p)); }
constexpr int AKP = 272, ATB = 32 * AKP;
struct NaMask { int on; int qc; int c0; int dr; int kc0; const LAS float* rpb; };
template <int DVT>
DEVI void attn_tile(f32x16 (&O)[DVT], float& m_run, float& l_run, const bf16x8 (&qf)[4], const LAS unsigned char* Kt, const LAS unsigned char* Vt, const NaMask nm, int lane) {
    const int r = lane & 31, h = lane >> 5, i16 = lane & 15, q = i16 >> 2, p = i16 & 3, blk = (lane >> 4) & 1;
    bf16x8 kf[4];
#pragma unroll
    for (int ks = 0; ks < 4; ++ks) kf[ks] = *(const LAS bf16x8*)(Kt + r * AKP + 32 * ks + 16 * h);
    f32x16 S;
#pragma unroll
    for (int i = 0; i < 16; ++i) S[i] = 0.f;
#pragma unroll
    for (int ks = 0; ks < 4; ++ks) S = MFMA32(kf[ks], qf[ks], S);
    if (nm.on) {
#pragma unroll
        for (int i = 0; i < 16; ++i) { const int kc = nm.kc0 + crow(i, h); const bool ok = (kc >= nm.c0) && (kc < nm.c0 + 16);
            int dc = kc - nm.qc + 15; dc = dc < 0 ? 0 : (dc > 30 ? 30 : dc);
            const float bias = nm.rpb[nm.dr * 31 + dc] * LOG2E;
            S[i] = ok ? S[i] + bias : -1e30f; }
    }
    float mx = S[0];
#pragma unroll
    for (int i = 1; i < 16; ++i) mx = fmaxf(mx, S[i]);
    mx = xhalf_max(mx);
    const float m_old = m_run, m_new = fmaxf(m_run, mx), alpha = __builtin_amdgcn_exp2f(m_run - m_new);
    float rs = 0.f;
#pragma unroll
    for (int i = 0; i < 16; ++i) { S[i] = __builtin_amdgcn_exp2f(S[i] - m_new); rs += S[i]; }
    rs = xhalf_sum(rs);
    l_run = l_run * alpha + rs; m_run = m_new;
    if (!__all(m_new == m_old)) {
#pragma unroll
        for (int dt = 0; dt < DVT; ++dt)
#pragma unroll
            for (int i = 0; i < 16; ++i) O[dt][i] *= alpha;
    }
    bf16x8 pf[2];
#pragma unroll
    for (int s = 0; s < 2; ++s) { v4u pk; pk.x = pk2(S[8 * s + 0], S[8 * s + 1]); pk.y = pk2(S[8 * s + 2], S[8 * s + 3]); pk.z = pk2(S[8 * s + 4], S[8 * s + 5]); pk.w = pk2(S[8 * s + 6], S[8 * s + 7]);
        pf[s] = __builtin_bit_cast(bf16x8, pk); }
    const LAS unsigned char* vb = Vt + (4 * h + q) * AKP + (16 * blk + 4 * p) * 2;
#pragma unroll
    for (int dt = 0; dt < DVT; ++dt)
#pragma unroll
        for (int s = 0; s < 2; ++s) { const s16x4 lo = vtr(vb + (16 * s) * AKP + 64 * dt), hi = vtr(vb + (16 * s + 8) * AKP + 64 * dt);
            const bf16x8 vf = __builtin_shufflevector(lo, hi, 0, 1, 2, 3, 4, 5, 6, 7);
            O[dt] = MFMA32(vf, pf[s], O[dt]); }
}
template <int NE, int DVT>
DEVI void attn_unit(f32x16 (&O)[DVT], float& m_run, float& l_run, const bf16x8 (&qf)[4], const bf16* K0, const bf16* V0, int ld0, int n0, const bf16* K1, const bf16* V1, int ld1, int n1,
                    int koffb, int na, int na_kmin, int na_gr, int na_qc, const LAS float* rpb_h, LAS unsigned char* lds, int tid, int lane) {
    const bool isV = (NE == 1) ? (tid >= 256) : false;
    const int row = (NE == 1) ? ((tid & 255) >> 3) : (tid >> 4), pc = (NE == 1) ? (tid & 7) : (tid & 15);
    v4u sa[NE], sb[NE], sc[NE];
#define AT_LOAD(st, kt_) do { const bool sg_ = (kt_) >= n0; const int kk_ = sg_ ? (kt_) - n0 : (kt_); const int ld_ = sg_ ? ld1 : ld0; const size_t ro_ = (size_t)(kk_ * 32 + row) * ld_ + pc * 8; \
        const bf16* kp_ = (sg_ ? K1 : K0) + ro_; const bf16* vp_ = (sg_ ? V1 : V0) + ro_; \
        if (NE == 1) st[0] = *(const v4u*)(isV ? vp_ : kp_); else { st[0] = *(const v4u*)kp_; st[NE - 1] = *(const v4u*)vp_; } } while (0)
#define AT_STORE(st, b_) do { LAS unsigned char* kb_ = lds + (b_) * 2 * ATB + row * AKP + pc * 16; \
        if (NE == 1) *(LAS v4u*)(kb_ + (isV ? ATB : 0)) = st[0]; else { *(LAS v4u*)kb_ = st[0]; *(LAS v4u*)(kb_ + ATB) = st[NE - 1]; } } while (0)
    const int nt = n0 + n1;
    int kr0 = na_gr - 4; kr0 = kr0 < 0 ? 0 : (kr0 > 24 ? 24 : kr0);
    int c0 = na_qc - 8; c0 = c0 < 0 ? 0 : (c0 > 48 ? 48 : c0);
    AT_LOAD(sa, 0); AT_STORE(sa, 0);
    AT_LOAD(sa, 1);
    AT_LOAD(sb, 2);
    __syncthreads();
#define AT_ITER(kt, st_store, st_load) do { \
        { const int lt_ = ((kt) + 3 < nt) ? (kt) + 3 : nt - 1; AT_LOAD(st_load, lt_); }     \
        NaMask nm{0, 0, 0, 0, 0, nullptr}; bool active = true; \
        if (na && (kt) >= n0) { const int j = (kt) - n0, krow = na_kmin + (j >> 1); active = (krow >= kr0) && (krow < kr0 + 8); nm = NaMask{1, na_qc, c0, krow - na_gr + 7, 32 * (j & 1), rpb_h}; } \
        if (active) attn_tile<DVT>(O, m_run, l_run, qf, lds + ((kt) & 1) * 2 * ATB + koffb, lds + ((kt) & 1) * 2 * ATB + ATB, nm, lane); \
        if ((kt) + 1 < nt) AT_STORE(st_store, ((kt) + 1) & 1); \
        asm volatile("s_waitcnt lgkmcnt(0)" ::: "memory"); __builtin_amdgcn_s_barrier(); asm volatile("" ::: "memory"); } while (0)
#pragma nounroll
    for (int kt = 0; kt < nt; kt += 3) {
        AT_ITER(kt, sa, sc);
        if (kt + 1 < nt) AT_ITER(kt + 1, sb, sa);
        if (kt + 2 < nt) AT_ITER(kt + 2, sc, sb);
    }
#undef AT_ITER
#undef AT_LOAD
#undef AT_STORE
}
template <int DVT, bool MASK>
DEVI void attn_tile64(f32x16 (&O)[DVT], float& m_run, float& l_run, const bf16x8 (&qf)[4], const LAS unsigned char* Kt, const LAS unsigned char* Vt, const NaMask nm, int lane) {
    const int r = lane & 31, h = lane >> 5, i16 = lane & 15, q = i16 >> 2, p = i16 & 3, blk = (lane >> 4) & 1;
    bf16x8 ka[4], kb[4];
#pragma unroll
    for (int ks = 0; ks < 4; ++ks) { ka[ks] = *(const LAS bf16x8*)(Kt + r * AKP + 32 * ks + 16 * h); kb[ks] = *(const LAS bf16x8*)(Kt + (32 + r) * AKP + 32 * ks + 16 * h); }
    f32x16 S0, S1;
#pragma unroll
    for (int i = 0; i < 16; ++i) { S0[i] = 0.f; S1[i] = 0.f; }
#pragma unroll
    for (int ks = 0; ks < 4; ++ks) { S0 = MFMA32(ka[ks], qf[ks], S0); S1 = MFMA32(kb[ks], qf[ks], S1); }
    if (MASK && nm.on) {
#pragma unroll
        for (int i = 0; i < 16; ++i) { const int kc = crow(i, h); const bool ok = (kc >= nm.c0) && (kc < nm.c0 + 16);
            int dc = kc - nm.qc + 15; dc = dc < 0 ? 0 : (dc > 30 ? 30 : dc);
            S0[i] = ok ? S0[i] + nm.rpb[nm.dr * 31 + dc] * LOG2E : -1e30f; }
#pragma unroll
        for (int i = 0; i < 16; ++i) { const int kc = 32 + crow(i, h); const bool ok = (kc >= nm.c0) && (kc < nm.c0 + 16);
            int dc = kc - nm.qc + 15; dc = dc < 0 ? 0 : (dc > 30 ? 30 : dc);
            S1[i] = ok ? S1[i] + nm.rpb[nm.dr * 31 + dc] * LOG2E : -1e30f; }
    }
    float mxa = fmaxf(fmaxf(fmaxf(S0[0], S0[1]), fmaxf(S0[2], S0[3])), fmaxf(fmaxf(S0[4], S0[5]), fmaxf(S0[6], S0[7])));
    float mxb = fmaxf(fmaxf(fmaxf(S0[8], S0[9]), fmaxf(S0[10], S0[11])), fmaxf(fmaxf(S0[12], S0[13]), fmaxf(S0[14], S0[15])));
    float mxc = fmaxf(fmaxf(fmaxf(S1[0], S1[1]), fmaxf(S1[2], S1[3])), fmaxf(fmaxf(S1[4], S1[5]), fmaxf(S1[6], S1[7])));
    float mxd = fmaxf(fmaxf(fmaxf(S1[8], S1[9]), fmaxf(S1[10], S1[11])), fmaxf(fmaxf(S1[12], S1[13]), fmaxf(S1[14], S1[15])));
    const float mx = xhalf_max(fmaxf(fmaxf(mxa, mxb), fmaxf(mxc, mxd)));
    const float m_old = m_run, m_new = fmaxf(m_run, mx), alpha = __builtin_amdgcn_exp2f(m_run - m_new);
#pragma unroll
    for (int i = 0; i < 16; ++i) { S0[i] = __builtin_amdgcn_exp2f(S0[i] - m_new); S1[i] = __builtin_amdgcn_exp2f(S1[i] - m_new); }
    const float ra = ((S0[0] + S0[1]) + (S0[2] + S0[3])) + ((S0[4] + S0[5]) + (S0[6] + S0[7])), rb = ((S0[8] + S0[9]) + (S0[10] + S0[11])) + ((S0[12] + S0[13]) + (S0[14] + S0[15]));
    const float rc = ((S1[0] + S1[1]) + (S1[2] + S1[3])) + ((S1[4] + S1[5]) + (S1[6] + S1[7])), rd = ((S1[8] + S1[9]) + (S1[10] + S1[11])) + ((S1[12] + S1[13]) + (S1[14] + S1[15]));
    const float rs = xhalf_sum((ra + rb) + (rc + rd));
    l_run = l_run * alpha + rs; m_run = m_new;
    if (!__all(m_new == m_old)) {
#pragma unroll
        for (int dt = 0; dt < DVT; ++dt)
#pragma unroll
            for (int i = 0; i < 16; ++i) O[dt][i] *= alpha;
    }
    bf16x8 pf[4];
#pragma unroll
    for (int s = 0; s < 2; ++s) { v4u pa, pb;
        pa.x = pk2(S0[8 * s + 0], S0[8 * s + 1]); pa.y = pk2(S0[8 * s + 2], S0[8 * s + 3]); pa.z = pk2(S0[8 * s + 4], S0[8 * s + 5]); pa.w = pk2(S0[8 * s + 6], S0[8 * s + 7]);
        pb.x = pk2(S1[8 * s + 0], S1[8 * s + 1]); pb.y = pk2(S1[8 * s + 2], S1[8 * s + 3]); pb.z = pk2(S1[8 * s + 4], S1[8 * s + 5]); pb.w = pk2(S1[8 * s + 6], S1[8 * s + 7]);
        pf[s] = __builtin_bit_cast(bf16x8, pa); pf[2 + s] = __builtin_bit_cast(bf16x8, pb); }
    const LAS unsigned char* vb = Vt + (4 * h + q) * AKP + (16 * blk + 4 * p) * 2;
#pragma unroll
    for (int s4 = 0; s4 < 4; ++s4)
#pragma unroll
        for (int dt = 0; dt < DVT; ++dt) { const s16x4 lo = vtr(vb + (16 * s4) * AKP + 64 * dt), hi = vtr(vb + (16 * s4 + 8) * AKP + 64 * dt);
            const bf16x8 vf = __builtin_shufflevector(lo, hi, 0, 1, 2, 3, 4, 5, 6, 7);
            O[dt] = MFMA32(vf, pf[s4], O[dt]); }
}
constexpr int ATB64 = 64 * AKP;
template <int NE, int DVT, bool NA = false>
DEVI void attn_unit64(f32x16 (&O)[DVT], float& m_run, float& l_run, const bf16x8 (&qf)[4], const bf16* K0, const bf16* V0, int ld0, int n0, const bf16* K1, const bf16* V1, int ld1, int n1,
                      int koffb, LAS unsigned char* lds, int tid, int lane, int na_kmin = 0, int na_gr = 0, int na_qc = 0, const LAS float* rpb_h = nullptr) {
    int kr0 = na_gr - 4; kr0 = kr0 < 0 ? 0 : (kr0 > 24 ? 24 : kr0);
    int c0 = na_qc - 8; c0 = c0 < 0 ? 0 : (c0 > 48 ? 48 : c0);
    const int row = (NE == 1) ? (tid >> 3) : (tid >> 4), pc = (NE == 1) ? (tid & 7) : (tid & 15);
    const int nt = n0 + n1;
    v4u ka_[NE], va_[NE], kb_[NE], vb_[NE];
#define A6_LOAD(kS, vS, kt_) do { const int kc_ = (kt_) < nt ? (kt_) : nt - 1; const bool sg_ = kc_ >= n0; const int kk_ = sg_ ? kc_ - n0 : kc_; const int ld_ = sg_ ? ld1 : ld0; \
        const bf16* kp_ = (sg_ ? K1 : K0) + (size_t)(kk_ * 64 + row) * ld_ + pc * 8; const bf16* vp_ = (sg_ ? V1 : V0) + (size_t)(kk_ * 64 + row) * ld_ + pc * 8; \
        _Pragma("unroll") for (int e_ = 0; e_ < NE; ++e_) { kS[e_] = *(const v4u*)(kp_ + (size_t)(32 * e_) * ld_); vS[e_] = *(const v4u*)(vp_ + (size_t)(32 * e_) * ld_); } } while (0)
#define A6_STORE(kS, vS, b_) do { LAS unsigned char* d_ = lds + (b_) * ATB64 + row * AKP + pc * 16; \
        _Pragma("unroll") for (int e_ = 0; e_ < NE; ++e_) { *(LAS v4u*)(d_ + (32 * e_) * AKP) = kS[e_]; *(LAS v4u*)(d_ + 2 * ATB64 + (32 * e_) * AKP) = vS[e_]; } } while (0)
#define A6_BAR() do { asm volatile("s_waitcnt lgkmcnt(0)" ::: "memory"); __builtin_amdgcn_s_barrier(); asm volatile("" ::: "memory"); } while (0)
    A6_LOAD(ka_, va_, 0); A6_STORE(ka_, va_, 0);
    A6_LOAD(ka_, va_, 1);
    A6_BAR();
#define A6_ITER(kt, kSt, vSt, kLd, vLd) do { \
        A6_LOAD(kLd, vLd, (kt) + 2); \
        NaMask nm{0, 0, 0, 0, 0, nullptr}; bool active = true; \
        if (NA && (kt) >= n0) { const int krow = na_kmin + ((kt) - n0); active = (krow >= kr0) && (krow < kr0 + 8); nm = NaMask{1, na_qc, c0, krow - na_gr + 7, 0, rpb_h}; } \
        if (active) attn_tile64<DVT, NA>(O, m_run, l_run, qf, lds + ((kt) & 1) * ATB64 + koffb, lds + (2 + ((kt) & 1)) * ATB64, nm, lane); \
        if ((kt) + 1 < nt) A6_STORE(kSt, vSt, ((kt) + 1) & 1); \
        A6_BAR(); } while (0)
#pragma nounroll
    for (int kt = 0; kt < nt; kt += 2) {
        A6_ITER(kt, ka_, va_, kb_, vb_);
        if (kt + 1 < nt) A6_ITER(kt + 1, kb_, vb_, ka_, va_);
    }
#undef A6_ITER
#undef A6_LOAD
#undef A6_STORE
#undef A6_BAR
}
DEVI void load_q(bf16x8 (&qf)[4], const bf16* Qb, int ldq, int lane) {
    const int r = lane & 31, h = lane >> 5;
#pragma unroll
    for (int ks = 0; ks < 4; ++ks) qf[ks] = *(const bf16x8*)(Qb + (size_t)r * ldq + 16 * ks + 8 * h);
}
template <int DVT> DEVI void zero_o(f32x16 (&O)[DVT]) {
#pragma unroll
    for (int dt = 0; dt < DVT; ++dt)
#pragma unroll
        for (int i = 0; i < 16; ++i) O[dt][i] = 0.f;
}
template <int DVT> DEVI void store_o(const f32x16 (&O)[DVT], float scale, bf16* out, int lane) {
    const int r = lane & 31, h = lane >> 5;
#pragma unroll
    for (int dt = 0; dt < DVT; ++dt)
#pragma unroll
        for (int g = 0; g < 4; ++g) { v2u w; w.x = pk2(O[dt][4 * g] * scale, O[dt][4 * g + 1] * scale); w.y = pk2(O[dt][4 * g + 2] * scale, O[dt][4 * g + 3] * scale);
            *(v2u*)(out + (size_t)r * D + 32 * dt + 8 * g + 4 * h) = w; }
}
DEVI void diff_combine(f32x16 (&O)[4], float inv_l, bool second, LAS float* xch, float lam, float lam_init, const float* dnw, bf16* out, int lane) {
    if (second) {
#pragma unroll
        for (int dt = 0; dt < 4; ++dt)
#pragma unroll
            for (int i = 0; i < 16; ++i) xch[(dt * 16 + i) * 64 + lane] = O[dt][i] * inv_l;
    }
    __syncthreads();
    if (!second) {
        const int r = lane & 31, h = lane >> 5;
        float ss = 0.f;
#pragma unroll
        for (int dt = 0; dt < 4; ++dt)
#pragma unroll
            for (int i = 0; i < 16; ++i) { const float v = O[dt][i] * inv_l - lam * xch[(dt * 16 + i) * 64 + lane]; O[dt][i] = v; ss += v * v; }
        ss = xhalf_sum(ss);
        const float rs = rsqrtf(ss * (1.0f / 128.0f) + NORM_EPS) * (1.0f - lam_init);
#pragma unroll
        for (int dt = 0; dt < 4; ++dt)
#pragma unroll
            for (int g = 0; g < 4; ++g) { const int dv = 32 * dt + 8 * g + 4 * h; const f32x4 nw = *(const f32x4*)(dnw + dv);
                v2u w; w.x = pk2(O[dt][4 * g] * rs * nw.x, O[dt][4 * g + 1] * rs * nw.y); w.y = pk2(O[dt][4 * g + 2] * rs * nw.z, O[dt][4 * g + 3] * rs * nw.w);
                *(v2u*)(out + (size_t)r * D + dv) = w; }
    }
    __syncthreads();
}
DEVI void o2_phase(const OddPtrs& P, bf16* MIXO, LAS unsigned char* lds, int blk, int tid, int wave, int lane) {
    LAS float* xch = (LAS float*)lds + (wave & 3) * 4096;
    const bf16* UB = P.UB;
    float lam;
    { const float p01 = wave_sum(P.dlam[lane] * P.dlam[64 + lane]), p23 = wave_sum(P.dlam[128 + lane] * P.dlam[192 + lane]); lam = __expf(p01) - __expf(p23) + P.lam_init; }
    const int sub = wave >> 2, qw = wave & 3;
    {
        lane = launder_v(lane);
        const int u = blk, qt = u & 15, h8 = (u >> 4) & 7, bs = u >> 7;
        const int mq = MP + bs * 2048 + qt * 128 + qw * 32;
        bf16x8 qf[4]; load_q(qf, UB + (size_t)mq * 6144 + 3072 + h8 * 128 + sub * 64, 6144, lane);
        f32x16 O[4]; zero_o<4>(O); float m_run = -1e30f, l_run = 0.f;
        const size_t cb = (size_t)((bs * 2 + P.li) * 256) * 1024 + h8 * 128, sb = (size_t)(MP + bs * 2048) * 6144 + h8 * 128;
        attn_unit64<2, 4>(O, m_run, l_run, qf, P.CDK + cb, P.CDV + cb, 1024, 4, UB + sb + 4096, UB + sb + 5120, 6144, 32, sub * 128, lds, tid, lane);
        diff_combine(O, 1.0f / l_run, sub == 1, xch, lam, P.lam_init, P.dnw, MIXO + (size_t)mq * D + 1024 + h8 * 128, lane);
    }
#pragma nounroll
    for (int rep = 0; rep < 2; ++rep) {
        lane = launder_v(lane);
        const int u = blk * 2 + rep, qt = u & 1, h8 = (u >> 1) & 7, b = u >> 4;
        const int mq = b * 256 + qt * 128 + qw * 32;
        bf16x8 qf[4]; load_q(qf, UB + (size_t)mq * 6144 + 3072 + h8 * 128 + sub * 64, 6144, lane);
        f32x16 O[4]; zero_o<4>(O); float m_run = -1e30f, l_run = 0.f;
        const size_t sb = (size_t)(b * 256) * 6144 + h8 * 128;
        attn_unit64<2, 4>(O, m_run, l_run, qf, UB + sb + 4096, UB + sb + 5120, 6144, 4, UB, UB, 6144, 0, sub * 128, lds, tid, lane);
        diff_combine(O, 1.0f / l_run, sub == 1, xch, lam, P.lam_init, P.dnw, MIXO + (size_t)mq * D + 1024 + h8 * 128, lane);
    }
    {
        lane = launder_v(lane);
        const int u = blk, g = u & 7, hd = (u >> 3) & 15, bs = u >> 7;
        const int gr = 4 * g + (wave >> 1), qh = wave & 1;
        const int mq = MP + bs * 2048 + gr * 64 + qh * 32;
        bf16x8 qf[4]; load_q(qf, UB + (size_t)mq * 6144 + hd * 64, 6144, lane);
        f32x16 O[2]; zero_o<2>(O); float m_run = -1e30f, l_run = 0.f;
        int kmin = 4 * g - 4; kmin = kmin < 0 ? 0 : (kmin > 24 ? 24 : kmin);
        int kmax = 4 * g + 3 - 4; kmax = (kmax < 0 ? 0 : (kmax > 24 ? 24 : kmax)) + 7;
        const size_t cb = (size_t)((bs * 2 + P.li) * 256) * 1024 + hd * 64, sb = (size_t)(MP + bs * 2048 + kmin * 64) * 6144 + hd * 64;
        LAS float* rpl = (LAS float*)(lds + 102400);
        if (tid < 465) rpl[tid] = P.rpb[hd * (15 * 31) + tid];
        __syncthreads();
        attn_unit64<1, 2, true>(O, m_run, l_run, qf, P.CNK + cb, P.CNV + cb, 1024, 4, UB + sb + 1024, UB + sb + 2048, 6144, kmax - kmin + 1, 0, lds, tid, lane, kmin, gr, qh * 32 + (lane & 31), rpl);
        store_o<2>(O, 1.0f / l_run, MIXO + (size_t)mq * D + hd * 64, lane);
    }
#pragma nounroll
    for (int rep = 0; rep < 2; ++rep) {
        lane = launder_v(lane);
        const int u = blk * 2 + rep, hd = u & 15, b = u >> 4;
        const int mq = b * 256 + wave * 32;
        bf16x8 qf[4]; load_q(qf, UB + (size_t)mq * 6144 + hd * 64, 6144, lane);
        f32x16 O[2]; zero_o<2>(O); float m_run = -1e30f, l_run = 0.f;
        const size_t sb = (size_t)(b * 256) * 6144 + hd * 64;
        attn_unit64<1, 2>(O, m_run, l_run, qf, UB + sb + 1024, UB + sb + 2048, 6144, 4, UB, UB, 6144, 0, 0, lds, tid, lane);
        store_o<2>(O, 1.0f / l_run, MIXO + (size_t)mq * D + hd * 64, lane);
    }
}

constexpr int CW_BAR = 4096;
constexpr int PO_NORM = 0, PO_MU = 49152, PO_W0 = 56128, PO_A0 = 60224, PO_KK = 64320, PO_KA = 66368, PO_RK = 68416, PO_LNW = 70464, PO_LNB = 72512, PO_LB = 74560,
              PO_HGNW = 78656, PO_RPB = 80704, PO_DLAM = 95584, PO_DNW = 96096, PO_END = 96352;
static_assert(WS_PAR + (size_t)PO_END * 4 <= WS_MOD, "parameter block");
DEVI KGAS unsigned char* launder(KGAS unsigned char* p) { asm volatile("" : "+s"(p)); return p; }
DEVI void copy_f32(const float* src, float* dst, int n, int gtid, int NT) { for (int i = gtid; i < n; i += NT) dst[i] = src[i]; }

__global__ void __launch_bounds__(NTHR, 2) fwd_kernel(Args a) {
    extern __shared__ __attribute__((aligned(16))) unsigned char lds_raw[];
    LAS unsigned char* lds = (LAS unsigned char*)lds_raw;
    const int tid0 = threadIdx.x, blk0 = blockIdx.x, G = gridDim.x;
#define PHASE_PRE KGAS unsigned char* ws = launder(a.ws); const int tid = launder_v(tid0), blk = launder_i(blk0), lane = tid & 63, wave = __builtin_amdgcn_readfirstlane(tid >> 6), \
        gw = blk * NWAVES + wave, NGW = G * NWAVES, gtid = blk * NTHR + tid, NT = G * NTHR; (void)ws; (void)lane; (void)gw; (void)NGW; (void)gtid; (void)NT;
#define WSRC(W) WSrc W; W.w1 = a.in[13]; W.w2 = a.in[14]; W.evin = a.in[15]; W.evout = a.in[16]; W.odin = a.in[30]; W.odout = a.in[31]; W.rw2 = a.in[19]; W.ra2 = a.in[21]; W.rg2 = a.in[22];
#define CONV_CTR(l_) ((unsigned*)(ws + WS_CTL) + 9216 + 64 * ((l_) + 1))
#define CONV_TAIL(S_) do { const int rounds_ = (S_.nwg + G - 1) / G; if ((S_.nwg % G) != 0 && (rounds_ - 1) * G + blk >= S_.nwg) { WSRC(W_); convert_tail(W_, ws, l, CONV_CTR(l), 9, 1 << 30, lds, tid, wave, lane); } } while (0)
    for (int u = tid0; u < (LDS_BYTES - LDSCTL_OFF) / 4; u += NTHR) ((LAS unsigned*)(lds + LDSCTL_OFF))[u] = 0u;
    __syncthreads();
    volatile LAS unsigned* MISC = (volatile LAS unsigned*)(lds + MISC_OFF);
    (void)xcd_barrier_post((unsigned*)(a.ws + WS_CTL) + CW_BAR, MISC + 8);
#define GRID_BAR() do { XcdBarrier bar_; bar_.bar = (unsigned*)(launder(a.ws) + WS_CTL) + CW_BAR; bar_.x = xb_xcc_id(); bar_.st = (volatile LAS unsigned*)(lds + MISC_OFF) + 8; xcd_barrier(bar_); } while (0)

    {
        PHASE_PRE
        float* MOD = (float*)(ws + WS_MOD); float* ROPE = (float*)(ws + WS_ROPE); float* PAR = (float*)(ws + WS_PAR);
        if (gtid == 0) { const float** pt_ = (const float**)(ws + WS_PTRS); pt_[0] = a.in[9]; pt_[1] = a.in[2]; pt_[2] = a.in[10]; pt_[3] = a.in[11]; }
        ada_cond(a.in[9], a.in[2], (LAS float*)lds, tid);
        for (int item = blk; item < 512; item += G) ada_item(a.in[10], a.in[11], MOD, (item >> 8) * 2, (item & 255) * 72, (const LAS float*)lds, (LAS float*)(lds + 24576), tid);
        if (gtid < 1024) { const int pos = gtid >> 4, pair = gtid & 15; const float inv = powf(10000.0f, -(float)pair * (1.0f / 16.0f)); float sn, cs; sincosf((float)pos * inv, &sn, &cs); ROPE[gtid * 2] = cs; ROPE[gtid * 2 + 1] = sn; }
        copy_f32(a.in[12], PAR + PO_NORM, 49152, gtid, NT); copy_f32(a.in[17], PAR + PO_MU, 6976, gtid, NT); copy_f32(a.in[18], PAR + PO_W0, 4096, gtid, NT); copy_f32(a.in[20], PAR + PO_A0, 4096, gtid, NT);
        copy_f32(a.in[23], PAR + PO_KK, 2048, gtid, NT); copy_f32(a.in[24], PAR + PO_KA, 2048, gtid, NT); copy_f32(a.in[25], PAR + PO_RK, 2048, gtid, NT); copy_f32(a.in[26], PAR + PO_LNW, 2048, gtid, NT);
        copy_f32(a.in[27], PAR + PO_LNB, 2048, gtid, NT); copy_f32(a.in[28], PAR + PO_LB, 4096, gtid, NT); copy_f32(a.in[29], PAR + PO_HGNW, 2048, gtid, NT); copy_f32(a.in[32], PAR + PO_RPB, 14880, gtid, NT);
        copy_f32(a.in[33], PAR + PO_DLAM, 512, gtid, NT); copy_f32(a.in[34], PAR + PO_DNW, 256, gtid, NT);
        for (int q = 0; q < 4; ++q) { const float* src = a.in[5 + q]; bf16* dst = (bf16*)(ws + WS_CCH) + (size_t)q * 1048576;
            for (int i = gtid; i < 262144; i += NT) { const f32x4 v = *(const f32x4*)(src + 4 * (size_t)i); v2u o; o.x = pk2(v.x, v.y); o.y = pk2(v.z, v.w); *(v2u*)(dst + 4 * (size_t)i) = o; } }
        __syncthreads();
        { WSRC(W); convert_tail(W, ws, -1, CONV_CTR(-1), 1 << 30, 1 << 30, lds, tid, wave, lane); }
    }
    GRID_BAR();
    { PHASE_PRE const float* MOD = (const float*)(ws + WS_MOD); const float* nw = (const float*)(ws + WS_PAR) + PO_NORM;
      row_phase<false, true, false, true>(a.in[0], a.in[1], nullptr, (bf16*)(ws + WS_X), (bf16*)(ws + WS_H), 0.f, MOD, 0, nw, MOD, 0, nw, lds, tid, gw, lane); }
    GRID_BAR();

#pragma nounroll
    for (int l = 0; l < 4; ++l) {
        const int li = l >> 1;
        { PHASE_PRE
          pg8::Gemm g{(const bf16*)(ws + WS_H), (const bf16*)(ws + WS_W1T) + (size_t)(l * 2) * NF1 * D, M, NF1, D, D}; pg8::StaticOrder S; S.init(M, NF1, G, blk); pg8::EpiSwiglu E{(bf16*)(ws + WS_ACT), FF};
          pg8::gemm_phase<pg8::EpiSwiglu, pg8::StaticOrder, true, true>(lds, g, S, E, tid); CONV_TAIL(S); }
        GRID_BAR();
        { PHASE_PRE
          pg8::Gemm g{(const bf16*)(ws + WS_ACT), (const bf16*)(ws + WS_W2T) + (size_t)(l * 2) * D * FF, M, D, FF, 2816}; pg8::StaticOrder S; S.init(M, D, G, blk, 2); pg8::EpiSlab E{(bf16*)(ws + WS_Y), D, (size_t)M * D};
          pg8::gemm_phase<pg8::EpiSlab, pg8::StaticOrder, true, true>(lds, g, S, E, tid); }
        GRID_BAR();
        { PHASE_PRE bf16* X = (bf16*)(ws + WS_X); const float* modl = (const float*)(ws + WS_MOD) + (size_t)l * 3 * NMOD; const float* nwl = (const float*)(ws + WS_PAR) + PO_NORM + (size_t)l * 6 * D;
          row_phase<true, true, true, true>(X, X + (size_t)MP * D, (const bf16*)(ws + WS_Y), X, (bf16*)(ws + WS_H), 0.5f, modl, 2, nwl + 1 * D, modl, 3, nwl + 2 * D, lds, tid, gw, lane); }
        GRID_BAR();
        if ((l & 1) == 0) { PHASE_PRE
          pg8::Gemm g{(const bf16*)(ws + WS_H), (const bf16*)(ws + WS_EVIN) + (size_t)li * EVP * D, M, EVP, D, D}; pg8::StaticOrder S; S.init(M, EVP, G, blk); pg8::EpiSlab E{(bf16*)(ws + WS_U), EVP, 0};
          pg8::gemm_phase<pg8::EpiSlab, pg8::StaticOrder, true, true>(lds, g, S, E, tid); CONV_TAIL(S); }
        else { PHASE_PRE
          pg8::Gemm g{(const bf16*)(ws + WS_H), (const bf16*)(ws + WS_ODIN) + (size_t)li * ODC * D, M, ODC, D, D}; pg8::StaticOrder S; S.init(M, ODC, G, blk);
          pg8::EpiOdd E{(bf16*)(ws + WS_UB), (const float*)(ws + WS_ROPE), a.out + OUT_NK, a.out + OUT_NV, a.out + OUT_DK, a.out + OUT_DV, li, QSCALE};
          pg8::gemm_phase<pg8::EpiOdd, pg8::StaticOrder, true, true>(lds, g, S, E, tid); CONV_TAIL(S); }
        GRID_BAR();
        if ((l & 1) == 0) {
#define EVEN_PTRS(P) EvenPtrs P; { KGAS unsigned char* ws = launder(a.ws); const float* PAR = (const float*)(ws + WS_PAR); \
            P.U = (const bf16*)(ws + WS_U); P.LR = (const bf16*)(ws + WS_LR); \
            P.RWV = (float*)(ws + WS_RWV); P.BONUS = (float*)(ws + WS_RWR); P.RWO = (float*)(ws + WS_RWO); P.HGO = (float*)(ws + WS_HGO); \
            P.mu = PAR + PO_MU + li * ACOLS; P.w0 = PAR + PO_W0 + li * 2048; P.a0 = PAR + PO_A0 + li * 2048; P.kk_w = PAR + PO_KK + li * 1024; P.ka_w = PAR + PO_KA + li * 1024; \
            P.r_k = PAR + PO_RK + li * 1024; P.ln_w = PAR + PO_LNW + li * 1024; P.ln_b = PAR + PO_LNB + li * 1024; P.lb0 = PAR + PO_LB; P.lb1 = PAR + PO_LB + 2048; P.hg_nw = PAR + PO_HGNW + li * 1024; P.li = li; }
            { PHASE_PRE e1a_phase((const bf16*)(ws + WS_U), (const float*)(ws + WS_PAR) + PO_MU + li * ACOLS, (bf16*)(ws + WS_L), gtid, NT); }
            GRID_BAR();
            { PHASE_PRE
              pg8::Gemm g{(const bf16*)(ws + WS_L), (const bf16*)(ws + WS_LRW) + (size_t)li * 5120 * LK, M, 5120, LK, -1}; pg8::StaticOrder S; S.init(M, 5120, G, blk); pg8::EpiSlab E{(bf16*)(ws + WS_LR), 5120, 0};
              pg8::gemm_phase<pg8::EpiSlab, pg8::StaticOrder, true, true>(lds, g, S, E, tid); }
            GRID_BAR();
            { PHASE_PRE EVEN_PTRS(P); e2_phase(P, a.in[3], a.in[4], a.out + OUT_SRW, a.out + OUT_SHG, (unsigned*)(ws + WS_CTL) + 8192 + 64 * li, lds, tid, wave, lane); }
            GRID_BAR();
            { PHASE_PRE EVEN_PTRS(P); e3_phase(P, (bf16*)(ws + WS_MIXO), gw, NGW, lane); }
            GRID_BAR();
        } else {
#define ODD_PTRS(P) OddPtrs P; { KGAS unsigned char* ws = launder(a.ws); const float* PAR = (const float*)(ws + WS_PAR); const bf16* CCH = (const bf16*)(ws + WS_CCH); \
            P.UB = (const bf16*)(ws + WS_UB); P.CNK = CCH; P.CNV = CCH + 1048576; P.CDK = CCH + 2 * 1048576; P.CDV = CCH + 3 * 1048576; \
            P.rpb = PAR + PO_RPB + li * 16 * 15 * 31; P.dlam = PAR + PO_DLAM + li * 256; P.dnw = PAR + PO_DNW + li * 128; \
            P.li = li; P.lam_init = 0.8f - 0.6f * __expf(-0.3f * (float)l); }
            { PHASE_PRE ODD_PTRS(P); o2_phase(P, (bf16*)(ws + WS_MIXO), lds, blk, tid, wave, lane); }
            GRID_BAR();
        }
        { PHASE_PRE
          const bf16* Bt = (l & 1) ? (const bf16*)(ws + WS_ODOUT) + (size_t)li * D * D : (const bf16*)(ws + WS_EVOUT) + (size_t)li * D * D;
          pg8::Gemm g{(const bf16*)(ws + WS_MIXO), Bt, M, D, D, 1024}; pg8::StaticOrder S; S.init(M, D, G, blk, 2); pg8::EpiSlab E{(bf16*)(ws + WS_Y), D, (size_t)M * D};
          pg8::gemm_phase<pg8::EpiSlab, pg8::StaticOrder, true, true>(lds, g, S, E, tid); }
        GRID_BAR();
        { PHASE_PRE bf16* X = (bf16*)(ws + WS_X); const float* modl = (const float*)(ws + WS_MOD) + (size_t)l * 3 * NMOD; const float* nwl = (const float*)(ws + WS_PAR) + PO_NORM + (size_t)l * 6 * D;
          { WSRC(W_); convert_tail(W_, ws, l, CONV_CTR(l), 1 << 30, list_w1b_end(l), lds, tid, wave, lane); }
          row_phase<true, true, true, true>(X, X + (size_t)MP * D, (const bf16*)(ws + WS_Y), X, (bf16*)(ws + WS_H), 1.0f, modl, 5, nwl + 3 * D, modl, 6, nwl + 4 * D, lds, tid, gw, lane); }
        GRID_BAR();
        { PHASE_PRE
          pg8::Gemm g{(const bf16*)(ws + WS_H), (const bf16*)(ws + WS_W1T) + (size_t)(l * 2 + 1) * NF1 * D, M, NF1, D, D}; pg8::StaticOrder S; S.init(M, NF1, G, blk); pg8::EpiSwiglu E{(bf16*)(ws + WS_ACT), FF};
          pg8::gemm_phase<pg8::EpiSwiglu, pg8::StaticOrder, true, true>(lds, g, S, E, tid); CONV_TAIL(S); }
        GRID_BAR();
        { PHASE_PRE
          pg8::Gemm g{(const bf16*)(ws + WS_ACT), (const bf16*)(ws + WS_W2T) + (size_t)(l * 2 + 1) * D * FF, M, D, FF, 2816}; pg8::StaticOrder S; S.init(M, D, G, blk, 2); pg8::EpiSlab E{(bf16*)(ws + WS_Y), D, (size_t)M * D};
          pg8::gemm_phase<pg8::EpiSlab, pg8::StaticOrder, true, true>(lds, g, S, E, tid); }
        GRID_BAR();
        { PHASE_PRE bf16* X = (bf16*)(ws + WS_X); const float* modl = (const float*)(ws + WS_MOD) + (size_t)l * 3 * NMOD; const float* nwl = (const float*)(ws + WS_PAR) + PO_NORM + (size_t)l * 6 * D;
          { WSRC(W_); convert_tail(W_, ws, l, CONV_CTR(l), 1 << 30, 1 << 30, lds, tid, wave, lane); }
          if (l < 3) row_phase<true, true, true, true>(X, X + (size_t)MP * D, (const bf16*)(ws + WS_Y), X, (bf16*)(ws + WS_H), 0.5f, modl, 8, nwl + 5 * D, modl + 3 * NMOD, 0, nwl + 6 * D, lds, tid, gw, lane);
          else row_phase<true, false, true, false>(X, X + (size_t)MP * D, (const bf16*)(ws + WS_Y), a.out + OUT_Y, nullptr, 0.5f, modl, 8, nwl + 5 * D, modl, 0, nwl, lds, tid, gw, lane); }
        if (l < 3) GRID_BAR();
    }
#undef GRID_BAR
}

extern "C" void kernel_launch(void* const* d_in, const int* in_sizes, int n_in, void* d_out, int out_size, void* d_ws, size_t ws_size, hipStream_t stream) {
    static int grid = 0;
    if (grid == 0) {
        if (n_in != 35 || (size_t)out_size != OUT_TOTAL || ws_size < WS_END) { fprintf(stderr, "kernel_launch: unexpected problem (n_in %d, out %d, ws %zu; need ws >= %zu)\n", n_in, out_size, ws_size, (size_t)WS_END); grid = -1; return; }
        int dev = 0, cus = 0, per_cu = 0;
        if (hipGetDevice(&dev) != hipSuccess || hipDeviceGetAttribute(&cus, hipDeviceAttributeMultiprocessorCount, dev) != hipSuccess) { grid = -1; return; }
        if (hipFuncSetAttribute((const void*)fwd_kernel, hipFuncAttributeMaxDynamicSharedMemorySize, LDS_BYTES) != hipSuccess) { fprintf(stderr, "kernel_launch: hipFuncSetAttribute failed\n"); grid = -1; return; }
        if (hipOccupancyMaxActiveBlocksPerMultiprocessor(&per_cu, (const void*)fwd_kernel, NTHR, LDS_BYTES) != hipSuccess || per_cu < 1) fprintf(stderr, "kernel_launch: occupancy query reports %d\n", per_cu);
        (void)hipGetLastError();
        if (cus != 256) fprintf(stderr, "kernel_launch: built for 256 CUs, device reports %d\n", cus);
        grid = 256;
    }
    if (grid < 0) return;
    (void)hipMemsetAsync((char*)d_ws + WS_CTL, 0, CTL_ZERO_BYTES, stream);
    Args a{};
    for (int i = 0; i < 35; ++i) a.in[i] = (const KGAS float*)d_in[i];
    a.out = (KGAS float*)d_out; a.ws = (KGAS unsigned char*)d_ws;
    hipLaunchKernelGGL(fwd_kernel, dim3(grid), dim3(NTHR), LDS_BYTES, stream, a);
}
```
